# Optimizing an MI355X kernel written in HIP

```python
import math, functools
import jax, jax.numpy as jnp
from jax import lax
import numpy as np

D_MODEL = 1024
BATCH = 8
SEQ = 4096
DEPTH = 4

GRID_W = 64
CTX_LEN = 256
N_MIXERS = 3
HEAD_DIM = 64
N_HEADS = D_MODEL // HEAD_DIM
GQA_KV_HEADS = N_HEADS // 4
GQA_REP = N_HEADS // GQA_KV_HEADS
DIFF_HEADS = D_MODEL // (2 * HEAD_DIM)
NA_WIN_H = 8
NA_WIN_W = 16
D_FF = 128 * ((8 * D_MODEL // 3 + 127) // 128)
ROPE_THETA = 10000.0
Q_BLOCK = 128
N_MOD = 9
EPS = 1e-6
N_NA = (DEPTH + 2) // 3
N_GQA = (DEPTH + 1) // 3
N_DIFF = DEPTH // 3

kernel_name = "hybrid_natten_gqa_diffattn_macaron_dit"


def rms_norm(x, g):
    xf = x.astype(jnp.float32)
    y = xf * lax.rsqrt(jnp.mean(xf * xf, axis=-1, keepdims=True) + EPS)
    return (y * g.astype(jnp.float32)).astype(x.dtype)


def pre(h, g, shift, scale):
    return rms_norm(h, g) * (1 + scale) + shift


def post_add(h, y, g, gate, weight):
    return h + weight * gate * rms_norm(y, g)


def swiglu(x, w_in, w_out):
    a, b = jnp.split(x @ w_in, 2, axis=-1)
    return (jax.nn.silu(a) * b) @ w_out


def rope_tables(n, dtype):
    t = jnp.arange(n, dtype=jnp.int32)
    row = (t // GRID_W).astype(jnp.float32)
    col = (t % GRID_W).astype(jnp.float32)
    nf = HEAD_DIM // 4
    inv = 1.0 / (ROPE_THETA ** (jnp.arange(nf, dtype=jnp.float32) / nf))
    ar = row[:, None] * inv
    ac = col[:, None] * inv
    cos = jnp.concatenate([jnp.cos(ar), jnp.cos(ar), jnp.cos(ac), jnp.cos(ac)], axis=-1)
    sin = jnp.concatenate([jnp.sin(ar), jnp.sin(ar), jnp.sin(ac), jnp.sin(ac)], axis=-1)
    return cos.astype(dtype), sin.astype(dtype)


def apply_rope(x, cos, sin):
    a, b, c2, d = jnp.split(x, 4, axis=-1)
    rot = jnp.concatenate([-b, a, -d, c2], axis=-1)
    shape = (1, cos.shape[0]) + (1,) * (x.ndim - 3) + (HEAD_DIM,)
    return x * cos.reshape(shape) + rot * sin.reshape(shape)


def sweep_query_blocks(fn, q):
    B, S = q.shape[:2]
    nb = S // Q_BLOCK
    qb = jnp.moveaxis(q.reshape((B, nb, Q_BLOCK) + q.shape[2:]), 1, 0)
    out = lax.map(fn, qb)
    return jnp.moveaxis(out, 0, 1).reshape((B, S) + out.shape[3:])


def gqa_attend(q, k, v):
    s = jnp.einsum('bqgrd,bkgd->bgrqk', q, k).astype(jnp.float32) * (HEAD_DIM ** -0.5)
    p = jax.nn.softmax(s, axis=-1).astype(v.dtype)
    return jnp.einsum('bgrqk,bkgd->bqgrd', p, v)


def natten_mixer(xl, xc, w_qkv, rpb, w_o, need_ctx):
    B, S, D = xl.shape
    L = xc.shape[1]
    rows = S // GRID_W
    kh = min(NA_WIN_H, rows)
    kw = NA_WIN_W
    n_nb = kh * GRID_W
    scale = HEAD_DIM ** -0.5
    qkv = (xl @ w_qkv).reshape(B, S, 3, N_HEADS, HEAD_DIM)
    q, k, v = qkv[:, :, 0], qkv[:, :, 1], qkv[:, :, 2]
    kvc = (xc @ w_qkv[:, D:]).reshape(B, L, 2, N_HEADS, HEAD_DIM)
    kc, vc = kvc[:, :, 0], kvc[:, :, 1]
    kg = k.reshape(B, rows, GRID_W, N_HEADS, HEAD_DIM)
    vg = v.reshape(B, rows, GRID_W, N_HEADS, HEAD_DIM)
    q_rows = jnp.moveaxis(q.reshape(B, rows, GRID_W, N_HEADS, HEAD_DIM), 1, 0)
    cpos = jnp.arange(GRID_W, dtype=jnp.int32)
    cstart = jnp.clip(cpos - kw // 2, 0, GRID_W - kw)
    col_ok = (cpos[None, :] >= cstart[:, None]) & (cpos[None, :] < cstart[:, None] + kw)
    mask = jnp.tile(col_ok, (1, kh))
    cidx = jnp.clip(cpos[None, :] - cpos[:, None] + NA_WIN_W - 1, 0, 2 * NA_WIN_W - 2)

    def row_block(args):
        qr, r = args
        rs = jnp.clip(r - kh // 2, 0, rows - kh)
        kb = lax.dynamic_slice_in_dim(kg, rs, kh, axis=1).reshape(B, n_nb, N_HEADS, HEAD_DIM)
        vb = lax.dynamic_slice_in_dim(vg, rs, kh, axis=1).reshape(B, n_nb, N_HEADS, HEAD_DIM)
        ridx = rs + jnp.arange(kh, dtype=jnp.int32) - r + NA_WIN_H - 1
        bias = rpb[:, ridx][:, :, cidx]
        bias = jnp.transpose(bias, (0, 2, 1, 3)).reshape(N_HEADS, GRID_W, n_nb)
        s_nb = jnp.einsum('bqhd,bkhd->bhqk', qr, kb).astype(jnp.float32) * scale + bias.astype(jnp.float32)
        s_nb = jnp.where(mask, s_nb, -jnp.inf)
        s_cx = jnp.einsum('bqhd,bkhd->bhqk', qr, kc).astype(jnp.float32) * scale
        p = jax.nn.softmax(jnp.concatenate([s_nb, s_cx], axis=-1), axis=-1).astype(vb.dtype)
        return (jnp.einsum('bhqk,bkhd->bqhd', p[..., :n_nb], vb)
                + jnp.einsum('bhqk,bkhd->bqhd', p[..., n_nb:], vc))

    o = lax.map(row_block, (q_rows, jnp.arange(rows, dtype=jnp.int32)))
    yl = jnp.moveaxis(o, 0, 1).reshape(B, S, D) @ w_o
    yc = None
    if need_ctx:
        qc = (xc @ w_qkv[:, :D]).reshape(B, L, N_HEADS, 1, HEAD_DIM)
        yc = gqa_attend(qc, kc, vc).reshape(B, L, D) @ w_o
    return yl, yc


def gqa_mixer(xl, xc, w_qkv, q_gain, k_gain, w_o, cos, sin, need_ctx):
    B, S, D = xl.shape
    L = xc.shape[1]
    dq = N_HEADS * HEAD_DIM
    dkv = GQA_KV_HEADS * HEAD_DIM
    qkv = xl @ w_qkv
    q = rms_norm(qkv[..., :dq].reshape(B, S, GQA_KV_HEADS, GQA_REP, HEAD_DIM), q_gain)
    k = rms_norm(qkv[..., dq:dq + dkv].reshape(B, S, GQA_KV_HEADS, HEAD_DIM), k_gain)
    v = qkv[..., dq + dkv:].reshape(B, S, GQA_KV_HEADS, HEAD_DIM)
    q = apply_rope(q, cos, sin)
    k = apply_rope(k, cos, sin)
    kvc = xc @ w_qkv[:, dq:]
    kc = rms_norm(kvc[..., :dkv].reshape(B, L, GQA_KV_HEADS, HEAD_DIM), k_gain)
    vc = kvc[..., dkv:].reshape(B, L, GQA_KV_HEADS, HEAD_DIM)
    k_all = jnp.concatenate([k, kc], axis=1)
    v_all = jnp.concatenate([v, vc], axis=1)
    o = sweep_query_blocks(lambda qb: gqa_attend(qb, k_all, v_all), q)
    yl = o.reshape(B, S, D) @ w_o
    yc = None
    if need_ctx:
        qc = rms_norm((xc @ w_qkv[:, :dq]).reshape(B, L, GQA_KV_HEADS, GQA_REP, HEAD_DIM), q_gain)
        yc = gqa_attend(qc, kc, vc).reshape(B, L, D) @ w_o
    return yl, yc


def diff_mixer(xl, xc, w_qkv, lam, subln_g, w_o, cos, sin, layer_idx, need_ctx):
    B, S, D = xl.shape
    L = xc.shape[1]
    dqk = 2 * DIFF_HEADS * HEAD_DIM
    lam_init = 0.8 - 0.6 * math.exp(-0.3 * layer_idx)
    lamf = lam.astype(jnp.float32)
    lam_full = (jnp.exp(jnp.sum(lamf[0] * lamf[1])) - jnp.exp(jnp.sum(lamf[2] * lamf[3])) + lam_init)

    def attend(q, k, v):
        s = jnp.einsum('bqihd,bkihd->bihqk', q, k).astype(jnp.float32) * (HEAD_DIM ** -0.5)
        p = jax.nn.softmax(s, axis=-1)
        a = (p[:, 0] - lam_full * p[:, 1]).astype(v.dtype)
        o = jnp.einsum('bhqk,bkhe->bqhe', a, v)
        return rms_norm(o, subln_g) * (1 - lam_init)

    qkv = xl @ w_qkv
    q = apply_rope(qkv[..., :dqk].reshape(B, S, 2, DIFF_HEADS, HEAD_DIM), cos, sin)
    k = apply_rope(qkv[..., dqk:2 * dqk].reshape(B, S, 2, DIFF_HEADS, HEAD_DIM), cos, sin)
    v = qkv[..., 2 * dqk:].reshape(B, S, DIFF_HEADS, 2 * HEAD_DIM)
    kvc = xc @ w_qkv[:, dqk:]
    kc = kvc[..., :dqk].reshape(B, L, 2, DIFF_HEADS, HEAD_DIM)
    vc = kvc[..., dqk:].reshape(B, L, DIFF_HEADS, 2 * HEAD_DIM)
    k_all = jnp.concatenate([k, kc], axis=1)
    v_all = jnp.concatenate([v, vc], axis=1)
    o = sweep_query_blocks(lambda qb: attend(qb, k_all, v_all), q)
    yl = o.reshape(B, S, D) @ w_o
    yc = None
    if need_ctx:
        qc = (xc @ w_qkv[:, :dqk]).reshape(B, L, 2, DIFF_HEADS, HEAD_DIM)
        yc = attend(qc, kc, vc).reshape(B, L, D) @ w_o
    return yl, yc


def setup_inputs(seed: int = 0) -> dict:
    key = jax.random.key(seed)
    ks = jax.random.split(key, 20)
    D = D_MODEL
    f32 = jnp.float32

    def w(k, shape, fan_in, mult=1.0):
        return jax.random.normal(k, shape, f32) * (mult * fan_in ** -0.5)

    dq = N_HEADS * HEAD_DIM
    dkv = GQA_KV_HEADS * HEAD_DIM
    return {
        "x": jax.random.normal(ks[0], (BATCH, SEQ, D), f32),
        "c": jax.random.normal(ks[1], (BATCH, D), f32),
        "ctx": jax.random.normal(ks[2], (BATCH, CTX_LEN, D), f32),
        "c_ctx": jax.random.normal(ks[3], (D,), f32),
        "w_mod": w(ks[4], (DEPTH, D, N_MOD * D), D, 0.5),
        "b_mod": 0.01 * jax.random.normal(ks[5], (DEPTH, N_MOD * D), f32),
        "norm_g": 1.0 + 0.05 * jax.random.normal(ks[6], (DEPTH, 6, D), f32),
        "w_ffn_in": w(ks[7], (DEPTH, 2, D, 2 * D_FF), D),
        "w_ffn_out": w(ks[8], (DEPTH, 2, D_FF, D), D_FF),
        "na_w_qkv": w(ks[9], (N_NA, D, 3 * D), D),
        "na_rpb": 0.1 * jax.random.normal(ks[10], (N_NA, N_HEADS, 2 * NA_WIN_H - 1, 2 * NA_WIN_W - 1), f32),
        "na_w_o": w(ks[11], (N_NA, D, D), D),
        "gqa_w_qkv": w(ks[12], (N_GQA, D, dq + 2 * dkv), D),
        "gqa_q_gain": 1.0 + 0.05 * jax.random.normal(ks[13], (N_GQA, HEAD_DIM), f32),
        "gqa_k_gain": 1.0 + 0.05 * jax.random.normal(ks[14], (N_GQA, HEAD_DIM), f32),
        "gqa_w_o": w(ks[15], (N_GQA, D, D), D),
        "diff_w_qkv": w(ks[16], (N_DIFF, D, 3 * D), D),
        "diff_lam": 0.1 * jax.random.normal(ks[17], (N_DIFF, 4, HEAD_DIM), f32),
        "diff_subln_g": 1.0 + 0.05 * jax.random.normal(ks[18], (N_DIFF, 2 * HEAD_DIM), f32),
        "diff_w_o": w(ks[19], (N_DIFF, D, D), D),
    }


def reference(x, c, ctx, c_ctx, w_mod, b_mod, norm_g, w_ffn_in, w_ffn_out,
              na_w_qkv, na_rpb, na_w_o,
              gqa_w_qkv, gqa_q_gain, gqa_k_gain, gqa_w_o,
              diff_w_qkv, diff_lam, diff_subln_g, diff_w_o):
    B, S, D = x.shape
    cos, sin = rope_tables(S, x.dtype)
    sc = jax.nn.silu(c)
    scc = jax.nn.silu(c_ctx)[None]
    h, hc = x, ctx
    for i in range(DEPTH):
        kind = i % N_MIXERS
        j = i // N_MIXERS
        last = i == DEPTH - 1
        mod = jnp.moveaxis((sc @ w_mod[i] + b_mod[i]).reshape(B, N_MOD, 1, D), 1, 0)
        modc = (scc @ w_mod[i] + b_mod[i]).reshape(N_MOD, 1, 1, D)
        g = norm_g[i]
        ffn1 = functools.partial(swiglu, w_in=w_ffn_in[i, 0], w_out=w_ffn_out[i, 0])
        ffn2 = functools.partial(swiglu, w_in=w_ffn_in[i, 1], w_out=w_ffn_out[i, 1])
        h = post_add(h, ffn1(pre(h, g[0], mod[0], mod[1])), g[1], mod[2], 0.5)
        hc = post_add(hc, ffn1(pre(hc, g[0], modc[0], modc[1])), g[1], modc[2], 0.5)
        xl = pre(h, g[2], mod[3], mod[4])
        xc = pre(hc, g[2], modc[3], modc[4])
        if kind == 0:
            yl, yc = natten_mixer(xl, xc, na_w_qkv[j], na_rpb[j], na_w_o[j], not last)
        elif kind == 1:
            yl, yc = gqa_mixer(xl, xc, gqa_w_qkv[j], gqa_q_gain[j], gqa_k_gain[j], gqa_w_o[j],
                               cos, sin, not last)
        else:
            yl, yc = diff_mixer(xl, xc, diff_w_qkv[j], diff_lam[j], diff_subln_g[j], diff_w_o[j],
                                cos, sin, i, not last)
        h = post_add(h, yl, g[3], mod[5], 1.0)
        h = post_add(h, ffn2(pre(h, g[4], mod[6], mod[7])), g[5], mod[8], 0.5)
        if not last:
            hc = post_add(hc, yc, g[3], modc[5], 1.0)
            hc = post_add(hc, ffn2(pre(hc, g[4], modc[6], modc[7])), g[5], modc[8], 0.5)
    return h
```

```cpp
#include <hip/hip_runtime.h>
#include <hip/hip_cooperative_groups.h>
#include <cstdio>
#include <cstdint>
#include <cmath>
namespace cg = cooperative_groups;
namespace pg8 {
#define PG8_LAS __attribute__((address_space(3)))
typedef unsigned short bf16_t;
typedef short bf16x8 __attribute__((ext_vector_type(8)));
typedef float f32x4 __attribute__((ext_vector_type(4)));
typedef unsigned u32x4 __attribute__((ext_vector_type(4)));
constexpr int BM = 256, BK = 64, HALF = 128, HTB = HALF * BK * 2  , STAGE_BYTES = 8 * HTB, NXCD = 8, WGM = 8;

__host__ __device__ __forceinline__ int lds_byte(int r, int c) { const int st = (r >> 4) * 2 + (c >> 5), rr = r & 15, cc = c & 31, ob = rr * 64 + cc * 2; return st * 1024 + (ob ^ (((ob >> 9) & 1) << 5)); }
__host__ __device__ __forceinline__ void stage_rc(int b, int& R, int& C) { const int st = b / 1024, sb = b % 1024, swz = sb ^ (((sb >> 9) & 1) << 5); R = (st >> 1) * 16 + swz / 64; C = (st & 1) * 32 + (swz % 64) / 2; }
__host__ __device__ __forceinline__ int perm32(int rho) { const int n = rho >> 4, i = rho & 15; return 8 * (i >> 2) + 4 * n + (i & 3); }

struct Unit { int pm, pn, k0, nt, ks; };
struct Gemm { const bf16_t* A; const bf16_t* Bt; int M, N, K; };

struct StaticOrder {
    int nM, nN, nwg, G, c, ntf;
    __host__ __device__ void init(int M, int N, int G_, int c_, int K_) { nM = M / BM; nN = N / BM; nwg = nM * nN; G = G_; c = c_; ntf = K_ / BK; }
    __host__ __device__ __forceinline__ bool next(int i, Unit& u) const {
        const long L = (long)i * G + c; const bool ok = L < nwg;
        int wgid = ok ? (int)L : 0; { const int q = nwg / NXCD, r = nwg % NXCD, xcd = wgid % NXCD, off = wgid / NXCD; wgid = (xcd < r ? xcd * (q + 1) : r * (q + 1) + (xcd - r) * q) + off; }
        const int nig = WGM * nN, gid = wgid / nig, fm = gid * WGM, gsz = (nM - fm) < WGM ? (nM - fm) : WGM;
        u.pm = fm + ((wgid % nig) % gsz); u.pn = (wgid % nig) / gsz; u.k0 = 0; u.nt = ntf; u.ks = -1; return ok;
    }
    __device__ __forceinline__ void a_ready(const Unit&) const {}
    __device__ __forceinline__ void done(const Unit&) const {}
};

constexpr int NSL = 4;
struct SplitOrder {
    StaticOrder S0; int nl, nitems, P;
    __host__ __device__ void init(int Mlat, int N, int G_, int c_, int K_, bool with_ctx) { S0.init(Mlat, N, G_, c_, K_); nl = c_ < S0.nwg ? (S0.nwg - c_ + G_ - 1) / G_ : 0; nitems = with_ctx ? 32 * NSL : 0; P = K_ / (2 * BK); }
    __host__ __device__ __forceinline__ bool next(int i, Unit& u) const {
        Unit w = {0, 0, 0, 0, -1}; const bool isw = i < nl; const bool okw = isw && S0.next(i, w);
        const long L = (long)(i - nl) * S0.G + S0.c; const bool oks = !isw && L < nitems;
        const int s = (int)L >> 5, q = (int)L & 31, base = P / NSL, rem = P % NSL;
        u.pm = isw ? w.pm : S0.nM + (q >> 2); u.pn = isw ? w.pn : (q & 3); u.ks = isw ? -1 : s; u.nt = isw ? w.nt : 2 * (base + (s < rem ? 1 : 0)); u.k0 = isw ? 0 : 2 * BK * (s * base + (s < rem ? s : rem));
        return okw || oks;
    }
    __device__ __forceinline__ void a_ready(const Unit&) const {}
    __device__ __forceinline__ void done(const Unit&) const {}
};

typedef float cvt_f32x2 __attribute__((ext_vector_type(2)));
typedef __bf16 cvt_bf16x2 __attribute__((ext_vector_type(2)));
__device__ __forceinline__ unsigned cvt_pk_bf16(float lo, float hi) { const cvt_f32x2 v = {lo, hi}; return __builtin_bit_cast(unsigned, __builtin_convertvector(v, cvt_bf16x2)); }
typedef float f32x2 __attribute__((ext_vector_type(2)));
__device__ __forceinline__ f32x2 gelu_pk(f32x2 v) {
    const f32x2 av = __builtin_elementwise_abs(v), d = av * 0.2316418882f + 1.0f;
    f32x2 t; t.x = __builtin_amdgcn_rcpf(d.x); t.y = __builtin_amdgcn_rcpf(d.y);
    f32x2 q = t * 0.5307027145f + (-0.7265760135f); q = q * t + 0.7107068705f; q = q * t + (-0.142248368f); q = q * t + 0.127414796f; q = q * t;
    const f32x2 s = (v * v) * (-0.72134752044f);
    f32x2 e; e.x = __builtin_amdgcn_exp2f(s.x); e.y = __builtin_amdgcn_exp2f(s.y);
    const f32x2 m = v * (q * e), r = v - m;
    f32x2 o; o.x = v.x < 0.f ? m.x : r.x; o.y = v.y < 0.f ? m.y : r.y; return o;
}

template <int ACT  > struct EpiBf16 {
    static constexpr bool PERM = true, AFTER_DRAIN = false; static_assert(ACT == 0 || ACT == 1, "EpiBf16: ACT is 0 (none) or 1 (gelu_pk)");
    bf16_t* O; int ldc; const float* bias; int split_cols; size_t split_stride; float scale0;
    __device__ __forceinline__ void operator()(const f32x4 (&acc)[2][2][4][2], const Unit& u, int wr, int wc, int fr, int fq) const {
        const int row0 = u.pm * BM + wr * 64 + fr; int colt = u.pn * BM; bf16_t* base = O;
        float sc = 1.f; if (split_cols) { const int t = colt / split_cols; base += (size_t)t * split_stride; colt -= t * split_cols; if (t == 0) sc = scale0; }
        const int col0 = colt + wc * 32 + 8 * fq, bcol0 = u.pn * BM + wc * 32 + 8 * fq;
        f32x4 bv[2][2];
#pragma unroll
        for (int bj = 0; bj < 2; ++bj)
#pragma unroll
            for (int n = 0; n < 2; ++n) bv[bj][n] = bias ? *(const f32x4*)(bias + bcol0 + bj * HALF + 4 * n) : (f32x4){0.f, 0.f, 0.f, 0.f};
#pragma unroll
        for (int ai = 0; ai < 2; ++ai)
#pragma unroll
            for (int m = 0; m < 4; ++m) { bf16_t* rowp = base + (size_t)(row0 + ai * HALF + m * 16) * ldc + col0;
#pragma unroll
                for (int bj = 0; bj < 2; ++bj) { f32x4 v0 = acc[ai][bj][m][0] + bv[bj][0], v1 = acc[ai][bj][m][1] + bv[bj][1];
                    if (ACT == 1) { f32x2 a = gelu_pk((f32x2){v0[0], v0[1]}), b = gelu_pk((f32x2){v0[2], v0[3]}), c = gelu_pk((f32x2){v1[0], v1[1]}), d = gelu_pk((f32x2){v1[2], v1[3]});
                        v0 = (f32x4){a.x, a.y, b.x, b.y}; v1 = (f32x4){c.x, c.y, d.x, d.y}; }
                    v0 = v0 * sc; v1 = v1 * sc; u32x4 w; w.x = cvt_pk_bf16(v0[0], v0[1]); w.y = cvt_pk_bf16(v0[2], v0[3]); w.z = cvt_pk_bf16(v1[0], v1[1]); w.w = cvt_pk_bf16(v1[2], v1[3]);
                    *(u32x4*)(rowp + bj * HALF) = w; } }
    }
};

typedef unsigned u32x2 __attribute__((ext_vector_type(2)));
struct EpiPlain {
    static constexpr bool PERM = true, AFTER_DRAIN = false;
    bf16_t* O; int ldc; float* P; int prow0;
    __device__ __forceinline__ void operator()(const f32x4 (&acc)[2][2][4][2], const Unit& u, int wr, int wc, int fr, int fq) const {
        const int row0 = u.pm * BM + wr * 64 + fr; const int col0 = u.pn * BM + wc * 32 + 8 * fq;
        if (u.ks >= 0) {
#pragma unroll
            for (int ai = 0; ai < 2; ++ai)
#pragma unroll
                for (int m = 0; m < 4; ++m) { float* rowp = P + ((size_t)u.ks * 2048 + (size_t)(row0 + ai * HALF + m * 16 - prow0)) * ldc + col0;
#pragma unroll
                    for (int bj = 0; bj < 2; ++bj) { *(f32x4*)(rowp + bj * HALF) = acc[ai][bj][m][0]; *(f32x4*)(rowp + bj * HALF + 4) = acc[ai][bj][m][1]; } }
            return;
        }
#pragma unroll
        for (int ai = 0; ai < 2; ++ai)
#pragma unroll
            for (int m = 0; m < 4; ++m) { bf16_t* rowp = O + (size_t)(row0 + ai * HALF + m * 16) * ldc + col0;
#pragma unroll
                for (int bj = 0; bj < 2; ++bj) { const f32x4 v0 = acc[ai][bj][m][0], v1 = acc[ai][bj][m][1];
                    u32x4 w; w.x = cvt_pk_bf16(v0[0], v0[1]); w.y = cvt_pk_bf16(v0[2], v0[3]); w.z = cvt_pk_bf16(v1[0], v1[1]); w.w = cvt_pk_bf16(v1[2], v1[3]);
                    *(u32x4*)(rowp + bj * HALF) = w; } }
    }
};
__device__ __forceinline__ float silu_mul(float a, float b) { return a * __builtin_amdgcn_rcpf(1.0f + __builtin_amdgcn_exp2f(-1.4426950408889634f * a)) * b; }
struct EpiSwiglu {
    static constexpr bool PERM = true, AFTER_DRAIN = false;
    bf16_t* O; int ldc;
    __device__ __forceinline__ void operator()(const f32x4 (&acc)[2][2][4][2], const Unit& u, int wr, int wc, int fr, int fq) const {
        const int row0 = u.pm * BM + wr * 64 + fr; const int col0 = u.pn * HALF + wc * 32 + 8 * fq;
#pragma unroll
        for (int ai = 0; ai < 2; ++ai)
#pragma unroll
            for (int m = 0; m < 4; ++m) { bf16_t* rowp = O + (size_t)(row0 + ai * HALF + m * 16) * ldc + col0;
                const f32x4 a0 = acc[ai][0][m][0], a1 = acc[ai][0][m][1], b0 = acc[ai][1][m][0], b1 = acc[ai][1][m][1];
                u32x4 w; w.x = cvt_pk_bf16(silu_mul(a0[0], b0[0]), silu_mul(a0[1], b0[1])); w.y = cvt_pk_bf16(silu_mul(a0[2], b0[2]), silu_mul(a0[3], b0[3]));
                w.z = cvt_pk_bf16(silu_mul(a1[0], b1[0]), silu_mul(a1[1], b1[1])); w.w = cvt_pk_bf16(silu_mul(a1[2], b1[2]), silu_mul(a1[3], b1[3]));
                *(u32x4*)rowp = w; }
    }
};
struct EpiQKV {
    static constexpr bool PERM = true, AFTER_DRAIN = false;
    bf16_t* O; int ldc; int kind;
    const float* rope;
    const float* qg; const float* kg;
    int nq, nk;
    __device__ __forceinline__ void operator()(const f32x4 (&acc)[2][2][4][2], const Unit& u, int wr, int wc, int fr, int fq) const {
        const int hs = 4 * u.pn + wc;
        const int type = hs < nq ? 0 : (hs < nq + nk ? 1 : 2);
        const bool latent = u.pm < 128;
        const bool do_norm = (kind == 1) && (type < 2);
        const bool do_rope = (kind != 0) && (type < 2) && latent;
        const float qs = (type == 0) ? 0.125f * 1.4426950408889634f : 1.0f;
        const int half = fq >> 1, jb = 8 * (fq & 1), D0 = 32 * half + jb;
        f32x4 ga[2], gb[2];
#pragma unroll
        for (int n = 0; n < 2; ++n) { ga[n] = do_norm ? *(const f32x4*)((type == 0 ? qg : kg) + D0 + 4 * n) : (f32x4){1.f, 1.f, 1.f, 1.f};
                                      gb[n] = do_norm ? *(const f32x4*)((type == 0 ? qg : kg) + D0 + 16 + 4 * n) : (f32x4){1.f, 1.f, 1.f, 1.f}; }
#pragma unroll
        for (int ai = 0; ai < 2; ++ai)
#pragma unroll
            for (int m = 0; m < 4; ++m) {
                const int row = u.pm * BM + ai * HALF + wr * 64 + m * 16 + fr;
                f32x4 a0 = acc[ai][0][m][0], a1 = acc[ai][0][m][1], b0 = acc[ai][1][m][0], b1 = acc[ai][1][m][1];
                if (do_norm) {
                    float ss = 0.f;
#pragma unroll
                    for (int e = 0; e < 4; ++e) ss += a0[e] * a0[e] + a1[e] * a1[e] + b0[e] * b0[e] + b1[e] * b1[e];
                    ss += __shfl_xor(ss, 16); ss += __shfl_xor(ss, 32);
                    const float r = __builtin_amdgcn_rsqf(ss * (1.0f / 64.0f) + 1e-6f);
                    a0 = a0 * r * ga[0]; a1 = a1 * r * ga[1]; b0 = b0 * r * gb[0]; b1 = b1 * r * gb[1];
                }
                if (do_rope) {
                    const int s = row & 4095, pos = half ? (s & 63) : (s >> 6);
                    const f32x4 c0 = *(const f32x4*)(rope + pos * 32 + jb), c1 = *(const f32x4*)(rope + pos * 32 + jb + 4);
                    const f32x4 s0 = *(const f32x4*)(rope + pos * 32 + 16 + jb), s1 = *(const f32x4*)(rope + pos * 32 + 16 + jb + 4);
                    const f32x4 x0 = a0, x1 = a1, y0 = b0, y1 = b1;
                    a0 = x0 * c0 - y0 * s0; b0 = y0 * c0 + x0 * s0; a1 = x1 * c1 - y1 * s1; b1 = y1 * c1 + x1 * s1;
                }
                a0 = a0 * qs; a1 = a1 * qs; b0 = b0 * qs; b1 = b1 * qs;
                bf16_t* rowp = O + (size_t)row * ldc + hs * 64 + D0;
                u32x4 w;
                w.x = cvt_pk_bf16(a0[0], a0[1]); w.y = cvt_pk_bf16(a0[2], a0[3]); w.z = cvt_pk_bf16(a1[0], a1[1]); w.w = cvt_pk_bf16(a1[2], a1[3]); *(u32x4*)(rowp) = w;
                w.x = cvt_pk_bf16(b0[0], b0[1]); w.y = cvt_pk_bf16(b0[2], b0[3]); w.z = cvt_pk_bf16(b1[0], b1[1]); w.w = cvt_pk_bf16(b1[2], b1[3]); *(u32x4*)(rowp + 16) = w;
            }
    }
};

template <class Epi, class Sched, bool ALIGN_EPI = false, bool SP2 = false>
__device__ __forceinline__ void gemm_phase(PG8_LAS unsigned char* lds, const Gemm g, const Sched& S, const Epi& E, const int tid_in) {
    int tid_ = tid_in; asm volatile("" : "+v"(tid_));
    const int tid = tid_, wid = __builtin_amdgcn_readfirstlane(tid >> 6), lane = tid & 63, wr = wid >> 2, wc = wid & 3, fr = lane & 15, fq = lane >> 4;
    const int K = g.K;
    unsigned voffA[2], voffB[2];
#pragma unroll
    for (int i = 0; i < 2; ++i) { int R, C; stage_rc(tid * 16 + i * 8192, R, C); const int Rb = Epi::PERM ? ((R & ~31) + perm32(R & 31)) : R;
        voffA[i] = (unsigned)(R * K + C) * 2u; voffB[i] = (unsigned)(Rb * K + C) * 2u; }
    const size_t kstep = (size_t)(BK * 2);
    const size_t hstep = (size_t)HALF * K * 2;
    const size_t tstep = 2 * hstep;
    const unsigned ldsw = (unsigned)wid * 1024u;
    const int aoff = lds_byte(wr * 64 + fr, fq * 8), boff = lds_byte(wc * 32 + fr, fq * 8);
#define PG8_SA(b, h) (((b) * 2 + (h)) * HTB)
#define PG8_SB(b, h) ((4 + (b) * 2 + (h)) * HTB)
#define PG8_STAGE(bufoff, gbase, voff) do { _Pragma("unroll") for (int _i = 0; _i < 2; ++_i) \
        __builtin_amdgcn_global_load_lds((const unsigned*)((const char*)(gbase) + (voff)[_i]), (PG8_LAS unsigned*)(lds + (bufoff) + ldsw + _i * 8192), 16, 0, 0); } while (0)
#define PG8_LDA(dst, b, h) do { _Pragma("unroll") for (int m = 0; m < 4; ++m) _Pragma("unroll") for (int k = 0; k < 2; ++k) dst[m][k] = *(const PG8_LAS bf16x8*)(lds + PG8_SA(b, h) + aoff + m * 2048 + k * 1024); } while (0)
#define PG8_LDB(dst, b, h) do { _Pragma("unroll") for (int n = 0; n < 2; ++n) _Pragma("unroll") for (int k = 0; k < 2; ++k) dst[n][k] = *(const PG8_LAS bf16x8*)(lds + PG8_SB(b, h) + boff + n * 2048 + k * 1024); } while (0)
#define PG8_MMA(ai, bj, At, Bt) do { __builtin_amdgcn_s_setprio(1); _Pragma("unroll") for (int m = 0; m < 4; ++m) _Pragma("unroll") for (int n = 0; n < 2; ++n) _Pragma("unroll") for (int k = 0; k < 2; ++k) \
        acc[ai][bj][m][n] = __builtin_amdgcn_mfma_f32_16x16x32_bf16(Bt[n][k], At[m][k], acc[ai][bj][m][n], 0, 0, 0); __builtin_amdgcn_s_setprio(0); } while (0)
#define PG8_WAIT_V(n) asm volatile("s_waitcnt vmcnt(" #n ")" ::: "memory")
#define PG8_WAIT_L(n) asm volatile("s_waitcnt lgkmcnt(" #n ")" ::: "memory")
#define PG8_BAR __builtin_amdgcn_s_barrier()
#define PG8_SCHED __builtin_amdgcn_sched_barrier(0)
    Unit cur, nxt; int ui = 0;
    if (!S.next(0, cur)) return;
    f32x4 acc[2][2][4][2];
#pragma unroll
    for (int a = 0; a < 2; ++a)
#pragma unroll
        for (int b = 0; b < 2; ++b)
#pragma unroll
            for (int m = 0; m < 4; ++m)
#pragma unroll
                for (int n = 0; n < 2; ++n) acc[a][b][m][n] = (f32x4){0.f, 0.f, 0.f, 0.f};
    bf16x8 At[4][2], B0[2][2], B1[2][2];
    const char* cA = (const char*)g.A + (size_t)cur.pm * tstep + (size_t)cur.k0 * 2; const char* cB = (const char*)g.Bt + (size_t)cur.pn * tstep + (size_t)cur.k0 * 2;
    S.a_ready(cur);
    if constexpr (SP2) {
        PG8_STAGE(PG8_SB(0, 0), cB, voffB); PG8_STAGE(PG8_SB(0, 1), cB + hstep, voffB); PG8_STAGE(PG8_SA(0, 0), cA, voffA); PG8_STAGE(PG8_SA(0, 1), cA + hstep, voffA);
        if (wr == 1) PG8_BAR;
        PG8_WAIT_V(2); PG8_BAR;
        PG8_STAGE(PG8_SB(1, 0), cB + kstep, voffB); PG8_STAGE(PG8_SA(1, 0), cA + kstep, voffA); PG8_STAGE(PG8_SB(1, 1), cB + hstep + kstep, voffB);
        PG8_WAIT_V(6); PG8_BAR;
    } else {
        PG8_STAGE(PG8_SB(0, 0), cB, voffB); PG8_STAGE(PG8_SA(0, 0), cA, voffA); PG8_STAGE(PG8_SB(0, 1), cB + hstep, voffB); PG8_STAGE(PG8_SA(0, 1), cA + hstep, voffA);
        if (wr == 1) PG8_BAR;
        PG8_WAIT_V(4); PG8_BAR;
        PG8_STAGE(PG8_SB(1, 0), cB + kstep, voffB); PG8_STAGE(PG8_SA(1, 0), cA + kstep, voffA); PG8_STAGE(PG8_SB(1, 1), cB + hstep + kstep, voffB);
        PG8_WAIT_V(6); PG8_BAR;
    }
    for (;;) {
        const bool has_next = S.next(ui + 1, nxt);
        const char* nA = has_next ? (const char*)g.A + (size_t)nxt.pm * tstep + (size_t)nxt.k0 * 2 : cA; const char* nB = has_next ? (const char*)g.Bt + (size_t)nxt.pn * tstep + (size_t)nxt.k0 * 2 : cB;
        const int nt = cur.nt;
        for (int t = 0; t < nt; t += 2) {
            const bool last = (t == nt - 2);
            const char* a1 = cA + (size_t)(t + 1) * kstep;
            const char* a2 = last ? nA : cA + (size_t)(t + 2) * kstep; const char* b2 = last ? nB : cB + (size_t)(t + 2) * kstep;
            const char* a3 = a2 + kstep; const char* b3 = b2 + kstep;
            if (last && has_next) S.a_ready(nxt);
            if constexpr (SP2) {
            PG8_LDB(B0, 0, 0); PG8_LDB(B1, 0, 1); PG8_SCHED; PG8_LDA(At, 0, 0); PG8_STAGE(PG8_SA(1, 1), a1 + hstep, voffA);
            PG8_WAIT_V(8); PG8_WAIT_L(0); PG8_BAR; PG8_MMA(0, 0, At, B0); PG8_MMA(0, 1, At, B1); PG8_BAR; PG8_SCHED;
            PG8_LDA(At, 0, 1); PG8_STAGE(PG8_SB(0, 0), b2, voffB); PG8_STAGE(PG8_SB(0, 1), b2 + hstep, voffB); PG8_STAGE(PG8_SA(0, 0), a2, voffA);
            PG8_WAIT_V(8); PG8_WAIT_L(0); PG8_BAR; PG8_MMA(1, 0, At, B0); PG8_MMA(1, 1, At, B1); PG8_BAR; PG8_SCHED;
            PG8_LDB(B0, 1, 0); PG8_LDB(B1, 1, 1); PG8_SCHED; PG8_LDA(At, 1, 0); PG8_STAGE(PG8_SA(0, 1), a2 + hstep, voffA);
            PG8_WAIT_V(8); PG8_WAIT_L(0); PG8_BAR; PG8_MMA(0, 0, At, B0); PG8_MMA(0, 1, At, B1); PG8_BAR; PG8_SCHED;
            PG8_LDA(At, 1, 1); PG8_STAGE(PG8_SB(1, 0), b3, voffB); PG8_STAGE(PG8_SB(1, 1), b3 + hstep, voffB); PG8_STAGE(PG8_SA(1, 0), a3, voffA);
            PG8_WAIT_V(8); PG8_WAIT_L(0); PG8_BAR; PG8_MMA(1, 0, At, B0); PG8_MMA(1, 1, At, B1); PG8_BAR; PG8_SCHED;
            } else {
            PG8_LDB(B0, 0, 0); PG8_SCHED; PG8_LDA(At, 0, 0); PG8_STAGE(PG8_SA(1, 1), a1 + hstep, voffA);
            PG8_WAIT_L(8); PG8_BAR; PG8_WAIT_L(0); PG8_MMA(0, 0, At, B0); PG8_BAR; PG8_SCHED;
            PG8_LDB(B1, 0, 1); PG8_STAGE(PG8_SB(0, 0), b2, voffB);
            PG8_BAR; PG8_WAIT_L(0); PG8_MMA(0, 1, At, B1); PG8_BAR;
            PG8_LDA(At, 0, 1); PG8_STAGE(PG8_SA(0, 0), a2, voffA);
            PG8_BAR; PG8_WAIT_L(0); PG8_MMA(1, 0, At, B0); PG8_BAR; PG8_SCHED;
            PG8_STAGE(PG8_SB(0, 1), b2 + hstep, voffB);
            PG8_WAIT_V(6); PG8_BAR; PG8_MMA(1, 1, At, B1); PG8_BAR;
            PG8_LDB(B0, 1, 0); PG8_SCHED; PG8_LDA(At, 1, 0); PG8_STAGE(PG8_SA(0, 1), a2 + hstep, voffA);
            PG8_WAIT_L(8); PG8_BAR; PG8_WAIT_L(0); PG8_MMA(0, 0, At, B0); PG8_BAR; PG8_SCHED;
            PG8_LDB(B1, 1, 1); PG8_STAGE(PG8_SB(1, 0), b3, voffB);
            PG8_BAR; PG8_WAIT_L(0); PG8_MMA(0, 1, At, B1); PG8_BAR;
            PG8_LDA(At, 1, 1); PG8_STAGE(PG8_SA(1, 0), a3, voffA);
            PG8_BAR; PG8_WAIT_L(0); PG8_MMA(1, 0, At, B0); PG8_BAR; PG8_SCHED;
            PG8_STAGE(PG8_SB(1, 1), b3 + hstep, voffB);
            PG8_WAIT_V(6); PG8_BAR; PG8_MMA(1, 1, At, B1); PG8_BAR;
            }
        }
        if constexpr (ALIGN_EPI) { if (wr == 0) PG8_BAR; }
        if constexpr (!Epi::AFTER_DRAIN) { E(acc, cur, wr, wc, fr, fq); S.done(cur); }
        if (!has_next) break;
#pragma unroll
        for (int a = 0; a < 2; ++a)
#pragma unroll
            for (int b = 0; b < 2; ++b)
#pragma unroll
                for (int m = 0; m < 4; ++m)
#pragma unroll
                    for (int n = 0; n < 2; ++n) acc[a][b][m][n] = (f32x4){0.f, 0.f, 0.f, 0.f};
        cur = nxt; cA = nA; cB = nB; ++ui;
        if constexpr (ALIGN_EPI) { if (wr == 1) PG8_BAR; }
    }
    PG8_WAIT_V(0);
    if constexpr (!ALIGN_EPI) { if (wr == 0) PG8_BAR; }
    PG8_BAR;
    if constexpr (Epi::AFTER_DRAIN) { E.fused(acc, cur, wr, wc, fr, fq, lds, wid, lane); S.done(cur); }
#undef PG8_SA
#undef PG8_SB
#undef PG8_STAGE
#undef PG8_LDA
#undef PG8_LDB
#undef PG8_MMA
#undef PG8_WAIT_V
#undef PG8_WAIT_L
#undef PG8_BAR
#undef PG8_SCHED
}
}

#define LAS __attribute__((address_space(3)))
typedef pg8::bf16_t bf16_t;
typedef pg8::bf16x8 bf16x8;
typedef pg8::f32x4 f32x4;
typedef pg8::u32x4 u32x4;
typedef pg8::u32x2 u32x2;
typedef float f32x16 __attribute__((ext_vector_type(16)));
typedef short s16x4 __attribute__((ext_vector_type(4)));

constexpr int M_LAT = 32768, M_CTX = 2048, MTOT = M_LAT + M_CTX, DM = 1024, DFF = 2816, NMOD = 9;
constexpr float LOG2E = 1.4426950408889634f;
constexpr int NTHREADS = 512;
constexpr int LDS_BYTES = pg8::STAGE_BYTES + 256;
constexpr int LDS_STAGE = pg8::STAGE_BYTES;

constexpr size_t WS_ROPE = 0;
constexpr size_t WS_BAR  = 16 * 1024;
constexpr size_t WS_MOD  = 64 * 1024;
constexpr size_t WS_WIN  = 2ull * 1024 * 1024;
constexpr size_t WS_WOUT = WS_WIN + 8ull * 5632 * 1024 * 2;
constexpr size_t WS_WQKV = WS_WOUT + 8ull * 1024 * 2816 * 2;
constexpr size_t WS_WO   = WS_WQKV + 4ull * 3072 * 1024 * 2;
constexpr size_t WS_H    = WS_WO + 4ull * 1024 * 1024 * 2;
constexpr size_t WS_U    = WS_H + (size_t)MTOT * 1024 * 4;
constexpr size_t WS_R1   = WS_U + (size_t)MTOT * 1024 * 2;
constexpr size_t WS_O    = WS_R1 + (size_t)MTOT * 3072 * 2;
constexpr size_t WS_END  = WS_O + (size_t)MTOT * 1024 * 2;

struct Args { const float* in[20]; float* out; unsigned char* ws; int ph_lo, ph_hi; float lam_init; int pad; };
typedef const __attribute__((address_space(4))) Args* CArgs;

__device__ __forceinline__ float wave_sum(float v) {
#pragma unroll
    for (int o = 1; o < 64; o <<= 1) v += __shfl_xor(v, o);
    return v;
}
__device__ __forceinline__ unsigned pk2(float lo, float hi) { return pg8::cvt_pk_bf16(lo, hi); }
__device__ __forceinline__ float bf_lo(unsigned w) { return __uint_as_float(w << 16); }
__device__ __forceinline__ float bf_hi(unsigned w) { return __uint_as_float(w & 0xffff0000u); }
__device__ __forceinline__ float hf_lo(unsigned w) { return (float)__builtin_bit_cast(_Float16, (unsigned short)(w & 0xffffu)); }
__device__ __forceinline__ float hf_hi(unsigned w) { return (float)__builtin_bit_cast(_Float16, (unsigned short)(w >> 16)); }
__device__ __forceinline__ unsigned pkh2(float lo, float hi) { return (unsigned)__builtin_bit_cast(unsigned short, (_Float16)lo) | ((unsigned)__builtin_bit_cast(unsigned short, (_Float16)hi) << 16); }

__device__ __forceinline__ void transpose_item(const float* W, int K, int N, bf16_t* WT, int k0, int n0, int drow0, LAS float* scr, int lane, int hi_off = 0) {
#pragma unroll 8
    for (int i = 0; i < 32; ++i) { const int kk = 2 * i + (lane >> 5); scr[kk * 33 + (lane & 31)] = W[(size_t)(k0 + kk) * N + n0 + (lane & 31)]; }
    asm volatile("s_waitcnt lgkmcnt(0)" ::: "memory");
    const int c = lane & 7;
#pragma unroll
    for (int j = 0; j < 4; ++j) { const int n = (lane >> 3) + 8 * j; const LAS float* s = scr + (8 * c) * 33 + n;
        u32x4 o; o.x = pk2(s[0 * 33], s[1 * 33]); o.y = pk2(s[2 * 33], s[3 * 33]); o.z = pk2(s[4 * 33], s[5 * 33]); o.w = pk2(s[6 * 33], s[7 * 33]);
        *(u32x4*)(WT + (size_t)(drow0 + n + (n >= 16 ? hi_off : 0)) * K + k0 + 8 * c) = o; }
    asm volatile("s_waitcnt lgkmcnt(0)" ::: "memory");
}

__device__ __forceinline__ void prologue(CArgs a, LAS unsigned char* lds, int tid, int wid, int lane) {
    unsigned char* ws = a->ws;
    if (blockIdx.x == 0) {
        for (int i = tid; i < 1024; i += NTHREADS) { const int pos = i >> 4, j = i & 15;
            const float inv = __builtin_amdgcn_exp2f(-(float)j * (13.287712379549449f / 16.0f)); const float rev = (float)pos * inv * 0.15915494309189535f;
            float* rt = (float*)(ws + WS_ROPE) + pos * 32; rt[j] = __builtin_amdgcn_cosf(rev); rt[16 + j] = __builtin_amdgcn_sinf(rev); }
    }
    {
        LAS float* sc = (LAS float*)lds;
        LAS float* red = (LAS float*)(lds + 9 * 1024 * 4);
        for (int i = tid; i < 9 * 1024; i += NTHREADS) { const int r = i >> 10, k = i & 1023; const float v = r < 8 ? a->in[1][r * 1024 + k] : a->in[3][k];
            sc[i] = v * __builtin_amdgcn_rcpf(1.0f + __builtin_amdgcn_exp2f(-LOG2E * v)); }
        __syncthreads();
        const int cl = tid & 63, ks = tid >> 6;
        for (int item = blockIdx.x; item < 4 * 144; item += gridDim.x) {
            const int layer = item / 144, cgp = item % 144;
            const float* wp = a->in[4] + (size_t)layer * 1024 * 9216 + (size_t)(ks * 128) * 9216 + cgp * 64 + cl;
            float acc[9];
#pragma unroll
            for (int r = 0; r < 9; ++r) acc[r] = 0.f;
#pragma unroll 8
            for (int k = 0; k < 128; ++k) { const float w = wp[(size_t)k * 9216];
#pragma unroll
                for (int r = 0; r < 9; ++r) acc[r] += sc[r * 1024 + ks * 128 + k] * w; }
#pragma unroll
            for (int r = 0; r < 9; ++r) red[(ks * 9 + r) * 64 + cl] = acc[r];
            __syncthreads();
            for (int o = tid; o < 9 * 64; o += NTHREADS) { const int r = o >> 6, cc = o & 63; float s = a->in[5][layer * 9216 + cgp * 64 + cc];
#pragma unroll
                for (int q = 0; q < 8; ++q) s += red[(q * 9 + r) * 64 + cc];
                ((float*)(ws + WS_MOD))[(size_t)(layer * 9 + r) * 9216 + cgp * 64 + cc] = s; }
            __syncthreads();
        }
    }
    __syncthreads();
    {
        LAS float* scr = (LAS float*)(lds + wid * 8704);
        const int gw = blockIdx.x * 8 + wid, NGW = gridDim.x * 8;
        constexpr int I_IN = 16 * 176, I_OUT = 44 * 32, I_Q3 = 16 * 96, I_Q15 = 16 * 48, I_O = 16 * 32;
        constexpr int T_IN = 8 * I_IN, T_OUT = 8 * I_OUT, T_QKV = 3 * I_Q3 + I_Q15, T_O = 4 * I_O;
        for (int it = gw; it < T_IN + T_OUT + T_QKV + T_O; it += NGW) {
            int r = it;
            if (r < T_IN) { const int mi = r / I_IN; r %= I_IN; const int kb = r / 176, nb = r % 176, n0 = nb * 32;
                const int bj = n0 / 2816, rem = n0 % 2816, drow0 = (rem >> 7) * 256 + bj * 128 + (rem & 127);
                transpose_item(a->in[7] + (size_t)mi * 1024 * 5632, 1024, 5632, (bf16_t*)(ws + WS_WIN) + (size_t)mi * 5632 * 1024, kb * 64, n0, drow0, scr, lane); continue; }
            r -= T_IN;
            if (r < T_OUT) { const int mi = r / I_OUT; r %= I_OUT; const int kb = r / 32, nb = r % 32;
                transpose_item(a->in[8] + (size_t)mi * 2816 * 1024, 2816, 1024, (bf16_t*)(ws + WS_WOUT) + (size_t)mi * 1024 * 2816, kb * 64, nb * 32, nb * 32, scr, lane); continue; }
            r -= T_OUT;
            if (r < T_QKV) {
                int layer, N; const float* src;
                if (r < I_Q3) { layer = 0; N = 3072; src = a->in[9]; }
                else if (r < I_Q3 + I_Q15) { r -= I_Q3; layer = 1; N = 1536; src = a->in[12]; }
                else if (r < 2 * I_Q3 + I_Q15) { r -= I_Q3 + I_Q15; layer = 2; N = 3072; src = a->in[16]; }
                else { r -= 2 * I_Q3 + I_Q15; layer = 3; N = 3072; src = a->in[9] + (size_t)1024 * 3072; }
                const int nbn = N / 32, kb = r / nbn, nb = r % nbn, n0 = nb * 32, hs = n0 >> 6, half = (n0 >> 5) & 1;
                const int drow0 = (hs >> 2) * 256 + (hs & 3) * 32 + 16 * half;
                transpose_item(src, 1024, N, (bf16_t*)(ws + WS_WQKV) + (size_t)layer * 3072 * 1024, kb * 64, n0, drow0, scr, lane, 112); continue; }
            r -= T_QKV;
            { const int layer = r / I_O; r %= I_O; const int kb = r / 32, nb = r % 32;
              const float* src = layer == 0 ? a->in[11] : (layer == 1 ? a->in[15] : (layer == 2 ? a->in[19] : a->in[11] + (size_t)1024 * 1024));
              transpose_item(src, 1024, 1024, (bf16_t*)(ws + WS_WO) + (size_t)layer * 1024 * 1024, kb * 64, nb * 32, nb * 32, scr, lane); }
        }
    }
}

template <int R, bool SRCB>
__device__ __forceinline__ void norm_rows(const int row0, const int mrow, const void* hp_, bf16_t* hout, float* final_out, const bf16_t* Y, const float* YP, const float w, const float* gpost, const float* gate,
                                          bf16_t* U, const float* gpre, const float* shift, const float* scale, const int lane) {
    f32x4 h[R][2][2]; u32x4 yr[R][2];
#pragma unroll
    for (int r = 0; r < R; ++r)
#pragma unroll
        for (int j = 0; j < 2; ++j) { const int c = 8 * lane + 512 * j;
            if (SRCB) { const u32x4 t = *(const u32x4*)((const bf16_t*)hp_ + (size_t)r * DM + c);
                h[r][j][0] = (f32x4){hf_lo(t.x), hf_hi(t.x), hf_lo(t.y), hf_hi(t.y)}; h[r][j][1] = (f32x4){hf_lo(t.z), hf_hi(t.z), hf_lo(t.w), hf_hi(t.w)}; }
            else { h[r][j][0] = *(const f32x4*)((const float*)hp_ + (size_t)r * DM + c); h[r][j][1] = *(const f32x4*)((const float*)hp_ + (size_t)r * DM + c + 4); }
            if (Y) yr[r][j] = *(const u32x4*)(Y + (size_t)(row0 + r) * DM + c); }
    if (Y) {
        f32x4 gg[2][2];
#pragma unroll
        for (int j = 0; j < 2; ++j)
#pragma unroll
            for (int k = 0; k < 2; ++k) { const int c = 8 * lane + 512 * j + 4 * k; gg[j][k] = *(const f32x4*)(gpost + c) * *(const f32x4*)(gate + (size_t)mrow * 9216 + c); }
#pragma unroll
        for (int r = 0; r < R; ++r) {
            f32x4 y[2][2]; float ss = 0.f;
#pragma unroll
            for (int j = 0; j < 2; ++j) { const u32x4 t = yr[r][j];
                y[j][0] = (f32x4){bf_lo(t.x), bf_hi(t.x), bf_lo(t.y), bf_hi(t.y)}; y[j][1] = (f32x4){bf_lo(t.z), bf_hi(t.z), bf_lo(t.w), bf_hi(t.w)};
                if (R == 1 && YP) {
#pragma unroll
                    for (int k = 0; k < 2; ++k) { const float* pp = YP + (size_t)(row0 - M_LAT) * DM + 8 * lane + 512 * j + 4 * k; f32x4 s = *(const f32x4*)pp;
#pragma unroll
                        for (int q = 1; q < pg8::NSL; ++q) s = s + *(const f32x4*)(pp + (size_t)q * 2048 * DM);
                        y[j][k] = s; } }
#pragma unroll
                for (int k = 0; k < 2; ++k) ss += (y[j][k][0] * y[j][k][0] + y[j][k][1] * y[j][k][1]) + (y[j][k][2] * y[j][k][2] + y[j][k][3] * y[j][k][3]); }
            const float rr = __builtin_amdgcn_rsqf(wave_sum(ss) * (1.0f / DM) + 1e-6f) * w;
#pragma unroll
            for (int j = 0; j < 2; ++j)
#pragma unroll
                for (int k = 0; k < 2; ++k) h[r][j][k] = h[r][j][k] + gg[j][k] * (y[j][k] * rr);
        }
    }
#pragma unroll
    for (int r = 0; r < R; ++r)
#pragma unroll
        for (int j = 0; j < 2; ++j) { const int c = 8 * lane + 512 * j;
            if (final_out) { *(f32x4*)(final_out + (size_t)(row0 + r) * DM + c) = h[r][j][0]; *(f32x4*)(final_out + (size_t)(row0 + r) * DM + c + 4) = h[r][j][1]; }
            else { u32x4 t; t.x = pkh2(h[r][j][0][0], h[r][j][0][1]); t.y = pkh2(h[r][j][0][2], h[r][j][0][3]); t.z = pkh2(h[r][j][1][0], h[r][j][1][1]); t.w = pkh2(h[r][j][1][2], h[r][j][1][3]);
                *(u32x4*)(hout + (size_t)(row0 + r) * DM + c) = t; } }
    if (U) {
        f32x4 gp[2][2], sc1[2][2], sh[2][2];
#pragma unroll
        for (int j = 0; j < 2; ++j)
#pragma unroll
            for (int k = 0; k < 2; ++k) { const int c = 8 * lane + 512 * j + 4 * k; gp[j][k] = *(const f32x4*)(gpre + c); sc1[j][k] = *(const f32x4*)(scale + (size_t)mrow * 9216 + c) + 1.0f; sh[j][k] = *(const f32x4*)(shift + (size_t)mrow * 9216 + c); }
#pragma unroll
        for (int r = 0; r < R; ++r) {
            float ss = 0.f;
#pragma unroll
            for (int j = 0; j < 2; ++j)
#pragma unroll
                for (int k = 0; k < 2; ++k) ss += (h[r][j][k][0] * h[r][j][k][0] + h[r][j][k][1] * h[r][j][k][1]) + (h[r][j][k][2] * h[r][j][k][2] + h[r][j][k][3] * h[r][j][k][3]);
            const float rr = __builtin_amdgcn_rsqf(wave_sum(ss) * (1.0f / DM) + 1e-6f);
#pragma unroll
            for (int j = 0; j < 2; ++j) { const f32x4 v0 = (h[r][j][0] * rr * gp[j][0]) * sc1[j][0] + sh[j][0], v1 = (h[r][j][1] * rr * gp[j][1]) * sc1[j][1] + sh[j][1];
                u32x4 t; t.x = pk2(v0[0], v0[1]); t.y = pk2(v0[2], v0[3]); t.z = pk2(v1[0], v1[1]); t.w = pk2(v1[2], v1[3]);
                *(u32x4*)(U + (size_t)(row0 + r) * DM + 8 * lane + 512 * j) = t; }
        }
    }
}
template <bool SRCB>
__device__ __forceinline__ void norm_phase(const void* hsrc_lat, const void* hsrc_ctx, bf16_t* hout, float* final_out, const bf16_t* Y, const float* YP, float w, const float* gpost, const float* gate,
                                           bf16_t* U, const float* gpre, const float* shift, const float* scale, const bool with_ctx, int wid, int lane) {
    const int gw = blockIdx.x * 8 + wid, NGW = gridDim.x * 8;
    for (int g = gw; g < M_LAT / 4; g += NGW) norm_rows<4, SRCB>(4 * g, g >> 10, SRCB ? (const void*)((const bf16_t*)hsrc_lat + (size_t)g * 4 * DM) : (const void*)((const float*)hsrc_lat + (size_t)g * 4 * DM), hout, final_out, Y, nullptr, w, gpost, gate, U, gpre, shift, scale, lane);
    if (with_ctx) for (int row = M_LAT + gw; row < MTOT; row += NGW) norm_rows<1, SRCB>(row, 8, SRCB ? (const void*)((const bf16_t*)hsrc_ctx + (size_t)(row - M_LAT) * DM) : (const void*)((const float*)hsrc_ctx + (size_t)(row - M_LAT) * DM), hout, final_out, Y, YP, w, gpost, gate, U, gpre, shift, scale, lane);
}

__device__ __forceinline__ int crow(int r, int hi) { return (r & 3) + 8 * (r >> 2) + 4 * hi; }
typedef float f32x2_t __attribute__((ext_vector_type(2)));
typedef __bf16 bf16x2_t __attribute__((ext_vector_type(2)));
__device__ __forceinline__ unsigned pk2n(float lo, float hi) { const f32x2_t v = {lo, hi}; return __builtin_bit_cast(unsigned, __builtin_convertvector(v, bf16x2_t)); }
__device__ __forceinline__ float max3f(float a, float b, float c) { float d; asm("v_max3_f32 %0, %1, %2, %3" : "=v"(d) : "v"(a), "v"(b), "v"(c)); return d; }

template <int KIND>
__device__ __forceinline__ void attn_phase(LAS unsigned char* lds, const bf16_t* qkv, const int N, bf16_t* O, const float* rpb, const float* lam, const float* subg, const float lam_init,
                                           const bool do_ctx, const int tid, const int wid, const int lane) {
    constexpr int HDV = KIND == 2 ? 128 : 64, NK = KIND == 2 ? 2 : 1, NDT = HDV / 32, NVC = HDV / 64;
    constexpr int KSTR = 144, VSTR = HDV * 2 + 64, KT = 64 * KSTR, KBUF = NK * KT, VBUF = 64 * VSTR;
    constexpr int OFF_V = 2 * KBUF, OFF_BIAS = OFF_V + 2 * VBUF;
    constexpr int QW = KIND == 2 ? 128 : 256;
    constexpr int SROW = HDV * 2 + 16, STG_OFF = KIND == 2 ? 81920 : 49152;
    static_assert(OFF_BIAS + 2048 <= STG_OFF && STG_OFF + (KIND == 2 ? 4 : 8) * 32 * SROW <= LDS_STAGE, "attention LDS map");
    const int l32 = lane & 31, hi = lane >> 5;
    float lam_full = 0.f;
    if (KIND == 2) { const float s01 = wave_sum(lam[lane] * lam[64 + lane]), s23 = wave_sum(lam[128 + lane] * lam[192 + lane]);
        lam_full = __builtin_amdgcn_exp2f(s01 * LOG2E) - __builtin_amdgcn_exp2f(s23 * LOG2E) + lam_init; }
    if (wid >= 4) __builtin_amdgcn_s_setprio(1);
    const int n_units = 2048 + (do_ctx ? 128 : 0);
    constexpr bool XPF = (KIND != 2);
    u32x4 kreg[NK], vreg[NVC]; bf16x8 qfN[4];
    const int krow_l = tid >> 3, kpart = tid & 7;
#define ATT_PREFETCH(U_) do { const int _u = (U_); const bool _ic = _u >= 2048; const int _uu = _ic ? _u - 2048 : _u; int _b, _h, _qb; const int _xw = _uu & 7, _jw = (_uu >> 3) & 31; \
        if (KIND == 1) { if (!_ic) { const int _it = (_xw >> 2) * 32 + _jw; _qb = _it & 15; _h = (_xw & 3) * 4 + (_it >> 4); _b = _uu >> 8; } else { _qb = 0; _h = _uu & 15; _b = _uu >> 4; } } \
        else { if (!_ic) { _qb = _jw & 15; _h = _xw + 8 * (_jw >> 4); _b = _uu >> 8; } else { _qb = 0; _h = _uu & 15; _b = _uu >> 4; } } \
        const int _qrow0 = _ic ? M_LAT + _b * 256 + _qb * QW : _b * 4096 + _qb * QW; \
        const int _kc = KIND == 1 ? 1024 + (_h >> 2) * 64 : 1024 + _h * 64, _vc = KIND == 0 ? 2048 + _h * 64 : 1280 + (_h >> 2) * 64; \
        const int _rb0 = _ic ? M_LAT + _b * 256 : (KIND == 0 ? _b * 4096 + min(max(_qb * 4 - 4, 0), 56) * 64 : _b * 4096); \
        const bf16_t* _qp = qkv + (size_t)(_qrow0 + 32 * wid + l32) * N + _h * 64 + 8 * hi; \
        _Pragma("unroll") for (int _t = 0; _t < 4; ++_t) qfN[_t] = *(const bf16x8*)(_qp + 16 * _t); \
        kreg[0] = *(const u32x4*)(qkv + (size_t)(_rb0 + krow_l) * N + _kc + kpart * 8); \
        vreg[0] = *(const u32x4*)(qkv + (size_t)(_rb0 + krow_l) * N + _vc + kpart * 8); } while (0)
    if (XPF && (int)blockIdx.x < n_units) ATT_PREFETCH((int)blockIdx.x);
    for (int u = blockIdx.x; u < n_units; u += gridDim.x) {
        const bool isctx = u >= 2048; const int uu = isctx ? u - 2048 : u;
        int b, h, qb;
        const int xw = uu & 7, jw = (uu >> 3) & 31;
        if (KIND == 2) { if (!isctx) { qb = jw; h = xw; b = uu >> 8; } else { qb = uu & 1; h = (uu >> 1) & 7; b = uu >> 4; } }
        else if (KIND == 1) { if (!isctx) { const int item = (xw >> 2) * 32 + jw; qb = item & 15; h = (xw & 3) * 4 + (item >> 4); b = uu >> 8; } else { qb = 0; h = uu & 15; b = uu >> 4; } }
        else           { if (!isctx) { qb = jw & 15; h = xw + 8 * (jw >> 4); b = uu >> 8; } else { qb = 0; h = uu & 15; b = uu >> 4; } }
        const int qrow0 = isctx ? M_LAT + b * 256 + qb * QW : b * 4096 + qb * QW;
        int qoff, hq, kidx;
        if (KIND == 2) { const int i = wid >> 2; qoff = 32 * (wid & 3); hq = i * 8 + h; kidx = i; } else { qoff = 32 * wid; hq = h; kidx = 0; }
        const int kcol0 = KIND == 1 ? 1024 + (h >> 2) * 64 : 1024 + h * 64;
        const int vcol = KIND == 0 ? 2048 + h * 64 : (KIND == 1 ? 1280 + (h >> 2) * 64 : 2048 + h * 128);
        int base1 = b * 4096, n1 = 64, kr_lo = 0, rs_w = 0, qr = 0, qc = 0, cs = 0;
        if (KIND == 0) { const int r0 = qb * 4; kr_lo = min(max(r0 - 4, 0), 56); const int kr_hi = min(max(r0 - 1, 0), 56) + 8; base1 += kr_lo * 64; n1 = kr_hi - kr_lo;
            qr = r0 + (wid >> 1); rs_w = min(max(qr - 4, 0), 56); qc = 32 * (wid & 1) + l32; cs = min(max(qc - 8, 0), 48); }
        if (isctx) n1 = 0;
        const int base2 = M_LAT + b * 256, nt = n1 + 4;

        bf16x8 qf[4];
        if (XPF) {
#pragma unroll
            for (int t = 0; t < 4; ++t) qf[t] = qfN[t];
        } else { const bf16_t* qp = qkv + (size_t)(qrow0 + qoff + l32) * N + hq * 64 + 8 * hi;
#pragma unroll
          for (int t = 0; t < 4; ++t) qf[t] = *(const bf16x8*)(qp + 16 * t); }
        if (KIND == 0 && !isctx) { LAS float* bt = (LAS float*)(lds + OFF_BIAS); for (int i = tid; i < 465; i += NTHREADS) bt[i] = rpb[h * 465 + i] * LOG2E; }

#define ATT_LOAD(T) do { const int _t = (T); const int _rb = _t < n1 ? base1 + 64 * _t : base2 + 64 * (_t - n1); \
            _Pragma("unroll") for (int _c = 0; _c < NK; ++_c) kreg[_c] = *(const u32x4*)(qkv + (size_t)(_rb + krow_l) * N + kcol0 + _c * 512 + kpart * 8); \
            _Pragma("unroll") for (int _c = 0; _c < NVC; ++_c) { const int _ch = tid + _c * 512; const int _vr = _ch / (HDV / 8), _vp = _ch % (HDV / 8); \
                vreg[_c] = *(const u32x4*)(qkv + (size_t)(_rb + _vr) * N + vcol + _vp * 8); } } while (0)
#define ATT_STORE(B) do { const int _b = (B); \
            _Pragma("unroll") for (int _c = 0; _c < NK; ++_c) *(LAS u32x4*)(lds + _b * KBUF + _c * KT + krow_l * KSTR + kpart * 16) = kreg[_c]; \
            _Pragma("unroll") for (int _c = 0; _c < NVC; ++_c) { const int _ch = tid + _c * 512; const int _vr = _ch / (HDV / 8), _vp = _ch % (HDV / 8); \
                *(LAS u32x4*)(lds + OFF_V + _b * VBUF + _vr * VSTR + _vp * 16) = vreg[_c]; } } while (0)

        float m_ref = 0.f; int first = 1;
        f32x16 o[NDT], lacc, mneg;
#pragma unroll
        for (int dt = 0; dt < NDT; ++dt)
#pragma unroll
            for (int j = 0; j < 16; ++j) o[dt][j] = 0.f;
#pragma unroll
        for (int j = 0; j < 16; ++j) { lacc[j] = 0.f; mneg[j] = 0.f; }
        const bf16x8 ones = {(short)0x3F80, (short)0x3F80, (short)0x3F80, (short)0x3F80, (short)0x3F80, (short)0x3F80, (short)0x3F80, (short)0x3F80};

        if (!XPF) ATT_LOAD(0);
        ATT_STORE(0); __syncthreads();
        const int koff = kidx * KT + l32 * KSTR + 16 * hi;
        const int voff = OFF_V + (4 * hi + ((lane & 15) >> 2)) * VSTR + (16 * ((lane >> 4) & 1) + 4 * (lane & 3)) * 2;
        const int wb = 4 * hi - cs;
        const int boff0 = OFF_BIAS + 4 * (cs - qc + 15 + wb);
        for (int t = 0; t < nt; ++t) {
            if (t + 1 < nt) ATT_LOAD(t + 1);
            else if (XPF && u + (int)gridDim.x < n_units) ATT_PREFETCH(u + (int)gridDim.x);
            bool active = true;
            if (KIND == 0 && t < n1) { const int kr = kr_lo + t; active = (kr >= rs_w) && (kr < rs_w + 8); }
            if (__builtin_amdgcn_readfirstlane((int)active)) {
                const int buf = t & 1;
                bf16x8 kf[8];
#pragma unroll
                for (int t4 = 0; t4 < 4; ++t4) { kf[2 * t4] = *(const LAS bf16x8*)(lds + buf * KBUF + koff + 32 * t4); kf[2 * t4 + 1] = *(const LAS bf16x8*)(lds + buf * KBUF + koff + 32 * KSTR + 32 * t4); }
                __builtin_amdgcn_sched_barrier(0);
                f32x16 s0, s1;
#pragma unroll
                for (int t4 = 0; t4 < 4; ++t4) {
                    s0 = __builtin_amdgcn_mfma_f32_32x32x16_bf16(kf[2 * t4], qf[t4], t4 == 0 ? mneg : s0, 0, 0, 0);
                    s1 = __builtin_amdgcn_mfma_f32_32x32x16_bf16(kf[2 * t4 + 1], qf[t4], t4 == 0 ? mneg : s1, 0, 0, 0);
                }
                float ab0[16], ab1[16];
                const bool na_lat = (KIND == 0) && (t < n1);
                if (na_lat) {
                    const int bo = boff0 + (kr_lo + t - qr + 7) * 124;
#pragma unroll
                    for (int j = 0; j < 16; ++j) {
                        const int C0 = 8 * (j >> 2) + (j & 3), C1 = 32 + C0;
                        const float b0 = *(const LAS float*)(lds + bo + 4 * C0), b1 = *(const LAS float*)(lds + bo + 4 * C1);
                        ab0[j] = ((unsigned)(wb + C0) < 16u) ? b0 : -1e30f;
                        ab1[j] = ((unsigned)(wb + C1) < 16u) ? b1 : -1e30f;
                    }
#pragma unroll
                    for (int i = 0; i < 8; ++i) { __builtin_amdgcn_sched_group_barrier(0x008, 1, 0); __builtin_amdgcn_sched_group_barrier(0x100, 4, 0); __builtin_amdgcn_sched_group_barrier(0x002, 12, 0); }
                }
                __builtin_amdgcn_sched_barrier(0);
                s16x4 vfa[2][NDT][2], vfb[2][NDT][2];
#pragma unroll
                for (int s = 0; s < 2; ++s)
#pragma unroll
                    for (int dt = 0; dt < NDT; ++dt) {
                        vfa[s][dt][0] = __builtin_amdgcn_ds_read_tr16_b64_v4i16((LAS s16x4*)(lds + buf * VBUF + voff + (16 * s) * VSTR + 64 * dt));
                        vfa[s][dt][1] = __builtin_amdgcn_ds_read_tr16_b64_v4i16((LAS s16x4*)(lds + buf * VBUF + voff + (16 * s + 8) * VSTR + 64 * dt)); }
                __builtin_amdgcn_sched_barrier(0);
                if (na_lat) {
#pragma unroll
                    for (int j = 0; j < 16; ++j) { s0[j] += ab0[j]; s1[j] += ab1[j]; }
                }
                const float mx0 = fmaxf(s1[15], s0[15]);
                float mxa = max3f(mx0, s0[0], s1[0]), mxb = max3f(mx0, s0[1], s1[1]);
#pragma unroll
                for (int j = 2; j < 15; j += 2) { mxa = max3f(mxa, s0[j], s1[j]); mxb = max3f(mxb, s0[j + 1], s1[j + 1]); }
                float mx = fmaxf(mxa, mxb);
                if (first || __builtin_amdgcn_ballot_w64(mx > 8.0f) != 0ull) {
                    mx = fmaxf(mx, __shfl_xor(mx, 32));
                    const float d = first ? mx : fmaxf(mx, 0.f);
                    const float alpha = first ? 1.0f : __builtin_amdgcn_exp2f(-d);
                    m_ref += d;
#pragma unroll
                    for (int j = 0; j < 16; ++j) { mneg[j] -= d; s0[j] -= d; s1[j] -= d; lacc[j] *= alpha; }
#pragma unroll
                    for (int dt = 0; dt < NDT; ++dt)
#pragma unroll
                        for (int j = 0; j < 16; ++j) o[dt][j] *= alpha;
                    first = 0;
                }
#pragma unroll
                for (int j = 0; j < 16; ++j) s0[j] = __builtin_amdgcn_exp2f(s0[j]);
                bf16x8 pf[4];
#pragma unroll
                for (int s = 0; s < 2; ++s) { u32x4 w; w.x = pk2n(s0[8 * s + 0], s0[8 * s + 1]); w.y = pk2n(s0[8 * s + 2], s0[8 * s + 3]); w.z = pk2n(s0[8 * s + 4], s0[8 * s + 5]); w.w = pk2n(s0[8 * s + 6], s0[8 * s + 7]);
                    pf[s] = __builtin_bit_cast(bf16x8, w); }
                __builtin_amdgcn_sched_barrier(0);
#pragma unroll
                for (int s = 0; s < 2; ++s)
#pragma unroll
                    for (int dt = 0; dt < NDT; ++dt) {
                        vfb[s][dt][0] = __builtin_amdgcn_ds_read_tr16_b64_v4i16((LAS s16x4*)(lds + buf * VBUF + voff + (16 * (s + 2)) * VSTR + 64 * dt));
                        vfb[s][dt][1] = __builtin_amdgcn_ds_read_tr16_b64_v4i16((LAS s16x4*)(lds + buf * VBUF + voff + (16 * (s + 2) + 8) * VSTR + 64 * dt)); }
                {
                    constexpr int NM = 2 * (1 + NDT);
                    int mi = 0;
#pragma unroll
                    for (int s = 0; s < 2; ++s) {
                        lacc = __builtin_amdgcn_mfma_f32_32x32x16_bf16(ones, pf[s], lacc, 0, 0, 0);
#pragma unroll
                        for (int j = (mi * 16) / NM; j < ((mi + 1) * 16) / NM; ++j) s1[j] = __builtin_amdgcn_exp2f(s1[j]);
                        ++mi;
#pragma unroll
                        for (int dt = 0; dt < NDT; ++dt) {
                            const s16x4 va = vfa[s][dt][0], vb = vfa[s][dt][1];
                            const bf16x8 vf = {va[0], va[1], va[2], va[3], vb[0], vb[1], vb[2], vb[3]};
                            o[dt] = __builtin_amdgcn_mfma_f32_32x32x16_bf16(vf, pf[s], o[dt], 0, 0, 0);
#pragma unroll
                            for (int j = (mi * 16) / NM; j < ((mi + 1) * 16) / NM; ++j) s1[j] = __builtin_amdgcn_exp2f(s1[j]);
                            ++mi;
                        }
                    }
#pragma unroll
                    for (int q = 0; q < 2; ++q) { u32x4 w; w.x = pk2n(s1[8 * q + 0], s1[8 * q + 1]); w.y = pk2n(s1[8 * q + 2], s1[8 * q + 3]); w.z = pk2n(s1[8 * q + 4], s1[8 * q + 5]); w.w = pk2n(s1[8 * q + 6], s1[8 * q + 7]);
                        pf[q + 2] = __builtin_bit_cast(bf16x8, w); }
#pragma unroll
                    for (int i = 0; i < NM; ++i) { __builtin_amdgcn_sched_group_barrier(0x008, 1, 0); __builtin_amdgcn_sched_group_barrier(0x402, (16 + NM - 1) / NM + 1, 0); }
                }
                __builtin_amdgcn_sched_barrier(0);
#pragma unroll
                for (int s = 0; s < 2; ++s) {
                    lacc = __builtin_amdgcn_mfma_f32_32x32x16_bf16(ones, pf[s + 2], lacc, 0, 0, 0);
#pragma unroll
                    for (int dt = 0; dt < NDT; ++dt) {
                        const s16x4 va = vfb[s][dt][0], vb = vfb[s][dt][1];
                        const bf16x8 vf = {va[0], va[1], va[2], va[3], vb[0], vb[1], vb[2], vb[3]};
                        o[dt] = __builtin_amdgcn_mfma_f32_32x32x16_bf16(vf, pf[s + 2], o[dt], 0, 0, 0);
                    }
                }
                __builtin_amdgcn_sched_barrier(0);
            }
            if (t + 1 < nt) ATT_STORE((t + 1) & 1);
            __syncthreads();
        }
#undef ATT_LOAD
#undef ATT_STORE
        const float l_tot = lacc[0];
        const float inv = 1.0f / l_tot;
        int lane_e = lane; asm volatile("" : "+v"(lane_e));
        const int l32e = lane_e & 31, hie = lane_e >> 5;
        const int orow = qrow0 + qoff + l32e;
        if (KIND != 2) {
            LAS unsigned char* stg = lds + STG_OFF + wid * (32 * SROW);
#pragma unroll
            for (int dt = 0; dt < NDT; ++dt)
#pragma unroll
                for (int g = 0; g < 4; ++g) { u32x2 w; w.x = pk2(o[dt][4 * g] * inv, o[dt][4 * g + 1] * inv); w.y = pk2(o[dt][4 * g + 2] * inv, o[dt][4 * g + 3] * inv);
                    *(LAS u32x2*)(stg + l32e * SROW + (32 * dt + 8 * g + 4 * hie) * 2) = w; }
            bf16_t* ob = O + (size_t)(qrow0 + qoff) * DM + hq * 64;
#pragma unroll
            for (int i = 0; i < 4; ++i) { const int c = lane_e + 64 * i, row = c >> 3, part = c & 7;
                const u32x4 v = *(const LAS u32x4*)(stg + row * SROW + part * 16);
                *(u32x4*)(ob + (size_t)row * DM + part * 8) = v; }
        } else {
            LAS float* cb = (LAS float*)lds + (size_t)(wid & 3) * (64 * 64) + lane_e;
            if (wid >= 4) {
#pragma unroll
                for (int dt = 0; dt < NDT; ++dt)
#pragma unroll
                    for (int j = 0; j < 16; ++j) cb[(dt * 16 + j) * 64] = o[dt][j] * inv;
            }
            __syncthreads();
            if (wid < 4) {
                float ss = 0.f;
#pragma unroll
                for (int dt = 0; dt < NDT; ++dt)
#pragma unroll
                    for (int j = 0; j < 16; ++j) { const float v = o[dt][j] * inv - lam_full * cb[(dt * 16 + j) * 64]; o[dt][j] = v; ss += v * v; }
                ss += __shfl_xor(ss, 32);
                float li_ = lam_init; asm volatile("" : "+v"(li_));
                const float r = __builtin_amdgcn_rsqf(ss * (1.0f / 128.0f) + 1e-6f) * (1.0f - li_);
                LAS unsigned char* stg = lds + STG_OFF + (wid & 3) * (32 * SROW);
#pragma unroll
                for (int dt = 0; dt < NDT; ++dt)
#pragma unroll
                    for (int g = 0; g < 4; ++g) { const f32x4 sg = *(const f32x4*)(subg + 32 * dt + 8 * g + 4 * hie);
                        u32x2 w; w.x = pk2(o[dt][4 * g] * r * sg[0], o[dt][4 * g + 1] * r * sg[1]); w.y = pk2(o[dt][4 * g + 2] * r * sg[2], o[dt][4 * g + 3] * r * sg[3]);
                        *(LAS u32x2*)(stg + l32e * SROW + (32 * dt + 8 * g + 4 * hie) * 2) = w; }
                bf16_t* ob = O + (size_t)(qrow0 + qoff) * DM + h * 128;
#pragma unroll
                for (int i = 0; i < 8; ++i) { const int c = lane_e + 64 * i, row = c >> 4, part = c & 15;
                    const u32x4 v = *(const LAS u32x4*)(stg + row * SROW + part * 16);
                    *(u32x4*)(ob + (size_t)row * DM + part * 8) = v; }
            }
            __syncthreads();
        }
    }
#undef ATT_PREFETCH
    __builtin_amdgcn_s_setprio(0);
}

#define XB_TMO      128
#define XB_XCNT(j)  (256  + 64 * (j))
#define XB_XSUB(j)  (1280 + 64 * (j))
#define XB_XGEN(j)  (2304 + 64 * (j))
#define XB_TOP      3328
#define XB_TOPGEN   3392
#define XCD_BAR_WORDS 3456
#define XB_SPIN_CAP (1u << 18)

__device__ __forceinline__ unsigned xb_ld(unsigned* p)              { return __hip_atomic_load(p, __ATOMIC_RELAXED, __HIP_MEMORY_SCOPE_AGENT); }
__device__ __forceinline__ unsigned xb_add(unsigned* p, unsigned v) { return __hip_atomic_fetch_add(p, v, __ATOMIC_RELAXED, __HIP_MEMORY_SCOPE_AGENT); }
__device__ __forceinline__ unsigned xb_xcc_id() { return (unsigned)__builtin_amdgcn_s_getreg((3 << 11) | 20) & 0xFu; }
#define XB_SPIN(cond, bar) do { unsigned _sp = 0; while (cond) { __builtin_amdgcn_s_sleep(1); \
    if ((++_sp & 255u) == 0u) { if (xb_ld(&(bar)[XB_TMO])) break; if (_sp > XB_SPIN_CAP) { atomicAdd(&(bar)[XB_TMO], 1u); break; } } } } while (0)

struct XcdBarrier {
    unsigned* bar; unsigned x;
    volatile LAS unsigned* st;
};

__device__ __forceinline__ XcdBarrier xcd_barrier_post(unsigned* bar, volatile LAS unsigned* st) {
    XcdBarrier b; b.bar = bar; b.x = xb_xcc_id(); b.st = st;
    if (threadIdx.x == 0) (void)xb_add(&bar[XB_XCNT(b.x)], 1u);
    return b;
}
__device__ __forceinline__ void xcd_barrier_complete(unsigned* bar, unsigned x, unsigned& nloc, unsigned& nx) {
    const unsigned G = gridDim.x * gridDim.y * gridDim.z;
    unsigned sum, cnt, mine, sp = 0u;
    for (;;) {
        sum = 0u; cnt = 0u; mine = 0u;
#pragma unroll
        for (unsigned j = 0; j < 16; ++j) { const unsigned c = xb_ld(&bar[XB_XCNT(j)]); sum += c; cnt += (c > 0u) ? 1u : 0u; mine = (j == x) ? c : mine; }
        if (sum == G) break;
        __builtin_amdgcn_s_sleep(1);
        if ((++sp & 255u) == 0u) { if (xb_ld(&bar[XB_TMO])) break; if (sp > XB_SPIN_CAP) { atomicAdd(&bar[XB_TMO], 1u); break; } }
    }
    nloc = mine > 0u ? mine : 1u; nx = cnt > 0u ? cnt : 1u;
}

__device__ __forceinline__ void xcd_barrier(const XcdBarrier& b) {
    asm volatile("s_waitcnt vmcnt(0)" ::: "memory");
    __syncthreads();
    if (threadIdx.x == 0) {
        unsigned* bar = b.bar;
        __builtin_amdgcn_s_waitcnt(0);
        unsigned nloc = b.st[0], nx = b.st[1];
        if (nloc == 0u) { xcd_barrier_complete(bar, b.x, nloc, nx); b.st[0] = nloc; b.st[1] = nx; }
        const unsigned old = xb_add(&bar[XB_XSUB(b.x)], 1u);
        const unsigned gen = old / nloc;
        if (old + 1u == (gen + 1u) * nloc) {
            __builtin_amdgcn_fence(__ATOMIC_RELEASE, "agent");
            asm volatile("s_waitcnt vmcnt(0)" ::: "memory");
            const unsigned og = xb_add(&bar[XB_TOP], 1u);
            const unsigned tg = og / nx;
            if (og + 1u == (tg + 1u) * nx) xb_add(&bar[XB_TOPGEN], 1u);
            else XB_SPIN(xb_ld(&bar[XB_TOPGEN]) == tg, bar);
            __builtin_amdgcn_fence(__ATOMIC_ACQUIRE, "agent");
            xb_add(&bar[XB_XGEN(b.x)], 1u);
            asm volatile("s_waitcnt vmcnt(0)" ::: "memory");
        } else {
            XB_SPIN(xb_ld(&bar[XB_XGEN(b.x)]) == gen, bar);
            __builtin_amdgcn_fence(__ATOMIC_ACQUIRE, "agent");
            asm volatile("s_waitcnt vmcnt(0)" ::: "memory");
        }
    }
    __syncthreads();
}

#ifndef EN
#define EN 511
#endif
#ifndef REP_GEMM
#define REP_GEMM 1
#endif
#ifndef REP_MASK
#define REP_MASK 0x3ff
#endif
#ifndef REP_NORM
#define REP_NORM 1
#endif
#ifndef REP_ATT
#define REP_ATT 1
#endif
#ifndef EXTRA_SYNC
#define EXTRA_SYNC 0
#endif
#ifndef REP_PRO
#define REP_PRO 1
#endif
__global__ void __launch_bounds__(NTHREADS, 2) mega_fwd(Args a_unused) {
    CArgs a = (CArgs)__builtin_amdgcn_kernarg_segment_ptr();
    extern __shared__ __attribute__((aligned(16))) unsigned char lds_raw[];
    LAS unsigned char* lds = (LAS unsigned char*)lds_raw;
    cg::grid_group grid = cg::this_grid();
    const int wid0 = __builtin_amdgcn_readfirstlane((int)(threadIdx.x >> 6));
    volatile LAS unsigned* xst = (volatile LAS unsigned*)(lds + LDS_STAGE);
    if (threadIdx.x < 2) xst[threadIdx.x] = 0u;
    unsigned* barw = (unsigned*)(a->ws + WS_BAR);
    if (blockIdx.x == 0) for (int i = threadIdx.x; i < XCD_BAR_WORDS; i += NTHREADS) __hip_atomic_store(barw + i, 0u, __ATOMIC_RELAXED, __HIP_MEMORY_SCOPE_AGENT);
    __syncthreads();
    XcdBarrier bar; bar.bar = barw; bar.x = 0; bar.st = xst;
    int rep_left = -1;
    for (int ph = a->ph_lo; ph < a->ph_hi; ++ph) {
        asm volatile("" : "+s"(a));
        int lane_ = (int)__builtin_amdgcn_mbcnt_hi(~0u, __builtin_amdgcn_mbcnt_lo(~0u, 0u)); asm volatile("" : "+v"(lane_));
        int wid_ = wid0; asm volatile("" : "+s"(wid_));
        const int lane = lane_, wid = wid_, tid = wid * 64 + lane;
        unsigned char* ws = a->ws;
        bf16_t* H = (bf16_t*)(ws + WS_H); bf16_t* U = (bf16_t*)(ws + WS_U); bf16_t* ACT = (bf16_t*)(ws + WS_R1); bf16_t* QKV = (bf16_t*)(ws + WS_R1); bf16_t* OB = (bf16_t*)(ws + WS_O);
        const float* MOD = (const float*)(ws + WS_MOD); const float* ROPE = (const float*)(ws + WS_ROPE);
        const float* NG = a->in[6];
        if (ph == 0) { if (EN & 1) prologue(a, lds, tid, wid, lane); }
        else if (ph == 1) { if (EN & 2) norm_phase<false>(a->in[0], a->in[2], H, nullptr, nullptr, nullptr, 0.f, nullptr, nullptr, U, NG, MOD + 0 * 1024, MOD + 1 * 1024, true, wid, lane); }
        else {
            const int L = (ph - 2) / 10, st = (ph - 2) % 10;
            const float* modL = MOD + (size_t)L * 9 * 9216; const float* ngL = NG + (size_t)L * 6 * 1024;
            const int kind = L % 3;
            if (st == 0 || st == 7) {
                const int f = st == 0 ? 0 : 1;
                const int Mr = (L == 3 && f == 1) ? M_LAT : MTOT;
                pg8::Gemm g{U, (const bf16_t*)(ws + WS_WIN) + (size_t)(L * 2 + f) * 5632 * 1024, Mr, 5632, 1024}; pg8::StaticOrder S; S.init(Mr, 5632, (int)gridDim.x, (int)blockIdx.x, 1024);
                pg8::EpiSwiglu E{ACT, DFF};
                if (EN & 4) pg8::gemm_phase<pg8::EpiSwiglu, pg8::StaticOrder, true, true>(lds, g, S, E, tid);
            } else if (st == 1 || st == 8 || st == 5) {
                const int f = st == 1 ? 0 : 1;
                const bf16_t* A = st == 5 ? OB : ACT; const int K = st == 5 ? 1024 : DFF;
                const bf16_t* Bt = st == 5 ? (const bf16_t*)(ws + WS_WO) + (size_t)L * 1024 * 1024 : (const bf16_t*)(ws + WS_WOUT) + (size_t)(L * 2 + f) * 1024 * 2816;
                const bool wctx = !(L == 3 && st != 1);
                float* YP = (float*)(ws + WS_R1 + (st == 5 ? 0ull : 200ull * 1024 * 1024));
                pg8::Gemm g{A, Bt, MTOT, 1024, K}; pg8::SplitOrder S; S.init(M_LAT, 1024, (int)gridDim.x, (int)blockIdx.x, K, wctx);
                pg8::EpiPlain E{U, DM, YP, M_LAT};
                if (EN & 8) pg8::gemm_phase<pg8::EpiPlain, pg8::SplitOrder, true, true>(lds, g, S, E, tid);
            } else if (st == 3) {
                const int N = kind == 1 ? 1536 : 3072;
                pg8::Gemm g{U, (const bf16_t*)(ws + WS_WQKV) + (size_t)L * 3072 * 1024, MTOT, N, 1024}; pg8::StaticOrder S; S.init(MTOT, N, (int)gridDim.x, (int)blockIdx.x, 1024);
                pg8::EpiQKV E{QKV, N, kind, ROPE, a->in[13], a->in[14], 16, kind == 1 ? 4 : 16};
                if (EN & 16) pg8::gemm_phase<pg8::EpiQKV, pg8::StaticOrder, true, true>(lds, g, S, E, tid);
            } else if (st == 4) {
                const bool do_ctx = L < 3;
                if (kind == 0) { if (EN & 32) attn_phase<0>(lds, QKV, 3072, OB, a->in[10] + (size_t)(L / 3) * 16 * 465, nullptr, nullptr, 0.f, do_ctx, tid, wid, lane); }
                else if (kind == 1) { if (EN & 64) attn_phase<1>(lds, QKV, 1536, OB, nullptr, nullptr, nullptr, 0.f, do_ctx, tid, wid, lane); }
                else { if (EN & 128) attn_phase<2>(lds, QKV, 3072, OB, nullptr, a->in[17], a->in[18], a->lam_init, do_ctx, tid, wid, lane); }
            } else {
                const float w = st == 6 ? 1.0f : 0.5f;
                const int gi = st == 2 ? 1 : (st == 6 ? 3 : 5), gk = st == 2 ? 2 : (st == 6 ? 5 : 8);
                const bool fin = (st == 9 && L == 3);
                const float* gpre; const float* shift; const float* scale;
                if (st == 2) { gpre = ngL + 2 * 1024; shift = modL + 3 * 1024; scale = modL + 4 * 1024; }
                else if (st == 6) { gpre = ngL + 4 * 1024; shift = modL + 6 * 1024; scale = modL + 7 * 1024; }
                else { gpre = ngL + 6 * 1024; shift = modL + 9 * 9216; scale = modL + 9 * 9216 + 1024; }
#if REP_NORM > 1
                if (!fin) norm_phase<true>(H, H + (size_t)M_LAT * DM, (bf16_t*)(ws + WS_R1), nullptr, U, nullptr, w, ngL + gi * 1024, modL + gk * 1024, (bf16_t*)(ws + WS_R1 + 160ull * 1024 * 1024), gpre, shift, scale, !(L == 3 && st >= 6), wid, lane);
                __syncthreads();
#endif
                if (EN & 256) norm_phase<true>(H, H + (size_t)M_LAT * DM, H, fin ? a->out : nullptr, U, (const float*)(ws + WS_R1 + (st == 6 ? 0ull : 200ull * 1024 * 1024)), w, ngL + gi * 1024, modL + gk * 1024, fin ? nullptr : U, gpre, shift, scale, !(L == 3 && st >= 6), wid, lane);
            }
        }
#if REP_GEMM > 1 || REP_ATT > 1 || REP_PRO > 1
        {
            const int st_ = ph >= 2 ? (ph - 2) % 10 : -1;
            const int want = ph == 0 ? REP_PRO : (st_ == 4 ? REP_ATT : ((st_ == 0 || st_ == 1 || st_ == 3 || st_ == 5 || st_ == 7 || st_ == 8) ? (((REP_MASK >> st_) & 1) ? REP_GEMM : 1) : 1));
            if (rep_left < 0) rep_left = want - 1;
            if (rep_left > 0) { --rep_left; --ph; __syncthreads(); continue; }
            rep_left = -1;
        }
#endif
        if (ph + 1 < a->ph_hi) {
            if (ph == a->ph_lo) { grid.sync(); bar = xcd_barrier_post(barw, xst); }
            else xcd_barrier(bar);
            for (int e = 0; e < EXTRA_SYNC; ++e) xcd_barrier(bar);
        }
    }
}

#ifndef MK_LAUNCH_PER_PHASE
#define MK_LAUNCH_PER_PHASE 0
#endif
extern "C" void kernel_launch(void* const* d_in, const int* in_sizes, int n_in, void* d_out, int out_size, void* d_ws, size_t ws_size, hipStream_t stream) {
    static int grid = 0;
    if (grid == 0) {
        if (n_in != 20 || out_size != M_LAT * DM || ws_size < WS_END) { fprintf(stderr, "kernel_launch: unexpected shapes (n_in %d out %d ws %zu, need %zu)\n", n_in, out_size, ws_size, (size_t)WS_END); grid = -1; return; }
        int dev = 0, cus = 0, per_cu = 0;
        if (hipGetDevice(&dev) != hipSuccess || hipDeviceGetAttribute(&cus, hipDeviceAttributeMultiprocessorCount, dev) != hipSuccess) { grid = -1; return; }
        if (hipFuncSetAttribute((const void*)mega_fwd, hipFuncAttributeMaxDynamicSharedMemorySize, LDS_BYTES) != hipSuccess) { fprintf(stderr, "kernel_launch: hipFuncSetAttribute failed\n"); grid = -1; return; }
        if (hipOccupancyMaxActiveBlocksPerMultiprocessor(&per_cu, (const void*)mega_fwd, NTHREADS, LDS_BYTES) != hipSuccess || per_cu < 1) { fprintf(stderr, "kernel_launch: occupancy query says %d\n", per_cu); per_cu = 1; }
        (void)hipGetLastError();
        grid = cus;
    }
    if (grid < 0) return;
    Args a{};
    for (int i = 0; i < 20; ++i) a.in[i] = (const float*)d_in[i];
    a.out = (float*)d_out; a.ws = (unsigned char*)d_ws;
    a.lam_init = (float)(0.8 - 0.6 * exp(-0.3 * 2.0));
    constexpr int NPH = 42;
#if MK_LAUNCH_PER_PHASE
    for (int p = 0; p < NPH; ++p) { a.ph_lo = p; a.ph_hi = p + 1; hipLaunchKernelGGL(mega_fwd, dim3(grid), dim3(NTHREADS), LDS_BYTES, stream, a); }
#else
    a.ph_lo = 0; a.ph_hi = NPH;
    void* args[] = {&a};
    hipError_t e = hipLaunchCooperativeKernel((const void*)mega_fwd, dim3(grid), dim3(NTHREADS), args, LDS_BYTES, stream);
    if (e != hipSuccess) fprintf(stderr, "kernel_launch: cooperative launch failed: %s (grid %d)\n", hipGetErrorString(e), grid);
#endif
}
```

```cpp
#include <hip/hip_runtime.h>
#include <hip/hip_cooperative_groups.h>
#include <cstdio>
#include <cstdint>
#include <cmath>
namespace cg = cooperative_groups;
namespace pg8 {
#define PG8_LAS __attribute__((address_space(3)))
typedef unsigned short bf16_t;
typedef short bf16x8 __attribute__((ext_vector_type(8)));
typedef float f32x4 __attribute__((ext_vector_type(4)));
typedef unsigned u32x4 __attribute__((ext_vector_type(4)));
constexpr int BM = 256, BK = 64, HALF = 128, HTB = HALF * BK * 2  , STAGE_BYTES = 8 * HTB, NXCD = 8, WGM = 8;

__host__ __device__ __forceinline__ int lds_byte(int r, int c) { const int st = (r >> 4) * 2 + (c >> 5), rr = r & 15, cc = c & 31, ob = rr * 64 + cc * 2; return st * 1024 + (ob ^ (((ob >> 9) & 1) << 5)); }
__host__ __device__ __forceinline__ void stage_rc(int b, int& R, int& C) { const int st = b / 1024, sb = b % 1024, swz = sb ^ (((sb >> 9) & 1) << 5); R = (st >> 1) * 16 + swz / 64; C = (st & 1) * 32 + (swz % 64) / 2; }
__host__ __device__ __forceinline__ int perm32(int rho) { const int n = rho >> 4, i = rho & 15; return 8 * (i >> 2) + 4 * n + (i & 3); }

struct Unit { int pm, pn, k0, nt, ks; };
struct Gemm { const bf16_t* A; const bf16_t* Bt; int M, N, K; };

struct StaticOrder {
    int nM, nN, nwg, G, c, ntf;
    __host__ __device__ void init(int M, int N, int G_, int c_, int K_) { nM = M / BM; nN = N / BM; nwg = nM * nN; G = G_; c = c_; ntf = K_ / BK; }
    __host__ __device__ __forceinline__ bool next(int i, Unit& u) const {
        const long L = (long)i * G + c; const bool ok = L < nwg;
        int wgid = ok ? (int)L : 0; { const int q = nwg / NXCD, r = nwg % NXCD, xcd = wgid % NXCD, off = wgid / NXCD; wgid = (xcd < r ? xcd * (q + 1) : r * (q + 1) + (xcd - r) * q) + off; }
        const int nig = WGM * nN, gid = wgid / nig, fm = gid * WGM, gsz = (nM - fm) < WGM ? (nM - fm) : WGM;
        u.pm = fm + ((wgid % nig) % gsz); u.pn = (wgid % nig) / gsz; u.k0 = 0; u.nt = ntf; u.ks = -1; return ok;
    }
    __device__ __forceinline__ void a_ready(const Unit&) const {}
    __device__ __forceinline__ void done(const Unit&) const {}
};

constexpr int NSL = 4;
struct SplitOrder {
    StaticOrder S0; int nl, nitems, P;
    __host__ __device__ void init(int Mlat, int N, int G_, int c_, int K_, bool with_ctx) { S0.init(Mlat, N, G_, c_, K_); nl = c_ < S0.nwg ? (S0.nwg - c_ + G_ - 1) / G_ : 0; nitems = with_ctx ? 32 * NSL : 0; P = K_ / (2 * BK); }
    __host__ __device__ __forceinline__ bool next(int i, Unit& u) const {
        Unit w = {0, 0, 0, 0, -1}; const bool isw = i < nl; const bool okw = isw && S0.next(i, w);
        const long L = (long)(i - nl) * S0.G + S0.c; const bool oks = !isw && L < nitems;
        const int s = (int)L >> 5, q = (int)L & 31, base = P / NSL, rem = P % NSL;
        u.pm = isw ? w.pm : S0.nM + (q >> 2); u.pn = isw ? w.pn : (q & 3); u.ks = isw ? -1 : s; u.nt = isw ? w.nt : 2 * (base + (s < rem ? 1 : 0)); u.k0 = isw ? 0 : 2 * BK * (s * base + (s < rem ? s : rem));
        return okw || oks;
    }
    __device__ __forceinline__ void a_ready(const Unit&) const {}
    __device__ __forceinline__ void done(const Unit&) const {}
};

typedef float cvt_f32x2 __attribute__((ext_vector_type(2)));
typedef __bf16 cvt_bf16x2 __attribute__((ext_vector_type(2)));
__device__ __forceinline__ unsigned cvt_pk_bf16(float lo, float hi) { const cvt_f32x2 v = {lo, hi}; return __builtin_bit_cast(unsigned, __builtin_convertvector(v, cvt_bf16x2)); }
typedef float f32x2 __attribute__((ext_vector_type(2)));
__device__ __forceinline__ f32x2 gelu_pk(f32x2 v) {
    const f32x2 av = __builtin_elementwise_abs(v), d = av * 0.2316418882f + 1.0f;
    f32x2 t; t.x = __builtin_amdgcn_rcpf(d.x); t.y = __builtin_amdgcn_rcpf(d.y);
    f32x2 q = t * 0.5307027145f + (-0.7265760135f); q = q * t + 0.7107068705f; q = q * t + (-0.142248368f); q = q * t + 0.127414796f; q = q * t;
    const f32x2 s = (v * v) * (-0.72134752044f);
    f32x2 e; e.x = __builtin_amdgcn_exp2f(s.x); e.y = __builtin_amdgcn_exp2f(s.y);
    const f32x2 m = v * (q * e), r = v - m;
    f32x2 o; o.x = v.x < 0.f ? m.x : r.x; o.y = v.y < 0.f ? m.y : r.y; return o;
}

template <int ACT  > struct EpiBf16 {
    static constexpr bool PERM = true, AFTER_DRAIN = false; static_assert(ACT == 0 || ACT == 1, "EpiBf16: ACT is 0 (none) or 1 (gelu_pk)");
    bf16_t* O; int ldc; const float* bias; int split_cols; size_t split_stride; float scale0;
    __device__ __forceinline__ void operator()(const f32x4 (&acc)[2][2][4][2], const Unit& u, int wr, int wc, int fr, int fq) const {
        const int row0 = u.pm * BM + wr * 64 + fr; int colt = u.pn * BM; bf16_t* base = O;
        float sc = 1.f; if (split_cols) { const int t = colt / split_cols; base += (size_t)t * split_stride; colt -= t * split_cols; if (t == 0) sc = scale0; }
        const int col0 = colt + wc * 32 + 8 * fq, bcol0 = u.pn * BM + wc * 32 + 8 * fq;
        f32x4 bv[2][2];
#pragma unroll
        for (int bj = 0; bj < 2; ++bj)
#pragma unroll
            for (int n = 0; n < 2; ++n) bv[bj][n] = bias ? *(const f32x4*)(bias + bcol0 + bj * HALF + 4 * n) : (f32x4){0.f, 0.f, 0.f, 0.f};
#pragma unroll
        for (int ai = 0; ai < 2; ++ai)
#pragma unroll
            for (int m = 0; m < 4; ++m) { bf16_t* rowp = base + (size_t)(row0 + ai * HALF + m * 16) * ldc + col0;
#pragma unroll
                for (int bj = 0; bj < 2; ++bj) { f32x4 v0 = acc[ai][bj][m][0] + bv[bj][0], v1 = acc[ai][bj][m][1] + bv[bj][1];
                    if (ACT == 1) { f32x2 a = gelu_pk((f32x2){v0[0], v0[1]}), b = gelu_pk((f32x2){v0[2], v0[3]}), c = gelu_pk((f32x2){v1[0], v1[1]}), d = gelu_pk((f32x2){v1[2], v1[3]});
                        v0 = (f32x4){a.x, a.y, b.x, b.y}; v1 = (f32x4){c.x, c.y, d.x, d.y}; }
                    v0 = v0 * sc; v1 = v1 * sc; u32x4 w; w.x = cvt_pk_bf16(v0[0], v0[1]); w.y = cvt_pk_bf16(v0[2], v0[3]); w.z = cvt_pk_bf16(v1[0], v1[1]); w.w = cvt_pk_bf16(v1[2], v1[3]);
                    *(u32x4*)(rowp + bj * HALF) = w; } }
    }
};

typedef unsigned u32x2 __attribute__((ext_vector_type(2)));
struct EpiPlain {
    static constexpr bool PERM = true, AFTER_DRAIN = false;
    bf16_t* O; int ldc; float* P; int prow0;
    __device__ __forceinline__ void operator()(const f32x4 (&acc)[2][2][4][2], const Unit& u, int wr, int wc, int fr, int fq) const {
        const int row0 = u.pm * BM + wr * 64 + fr; const int col0 = u.pn * BM + wc * 32 + 8 * fq;
        if (u.ks >= 0) {
#pragma unroll
            for (int ai = 0; ai < 2; ++ai)
#pragma unroll
                for (int m = 0; m < 4; ++m) { float* rowp = P + ((size_t)u.ks * 2048 + (size_t)(row0 + ai * HALF + m * 16 - prow0)) * ldc + col0;
#pragma unroll
                    for (int bj = 0; bj < 2; ++bj) { *(f32x4*)(rowp + bj * HALF) = acc[ai][bj][m][0]; *(f32x4*)(rowp + bj * HALF + 4) = acc[ai][bj][m][1]; } }
            return;
        }
#pragma unroll
        for (int ai = 0; ai < 2; ++ai)
#pragma unroll
            for (int m = 0; m < 4; ++m) { bf16_t* rowp = O + (size_t)(row0 + ai * HALF + m * 16) * ldc + col0;
#pragma unroll
                for (int bj = 0; bj < 2; ++bj) { const f32x4 v0 = acc[ai][bj][m][0], v1 = acc[ai][bj][m][1];
                    u32x4 w; w.x = cvt_pk_bf16(v0[0], v0[1]); w.y = cvt_pk_bf16(v0[2], v0[3]); w.z = cvt_pk_bf16(v1[0], v1[1]); w.w = cvt_pk_bf16(v1[2], v1[3]);
                    *(u32x4*)(rowp + bj * HALF) = w; } }
    }
};
__device__ __forceinline__ float silu_mul(float a, float b) { return a * __builtin_amdgcn_rcpf(1.0f + __builtin_amdgcn_exp2f(-1.4426950408889634f * a)) * b; }
struct EpiSwiglu {
    static constexpr bool PERM = true, AFTER_DRAIN = false;
    bf16_t* O; int ldc;
    __device__ __forceinline__ void operator()(const f32x4 (&acc)[2][2][4][2], const Unit& u, int wr, int wc, int fr, int fq) const {
        const int row0 = u.pm * BM + wr * 64 + fr; const int col0 = u.pn * HALF + wc * 32 + 8 * fq;
#pragma unroll
        for (int ai = 0; ai < 2; ++ai)
#pragma unroll
            for (int m = 0; m < 4; ++m) { bf16_t* rowp = O + (size_t)(row0 + ai * HALF + m * 16) * ldc + col0;
                const f32x4 a0 = acc[ai][0][m][0], a1 = acc[ai][0][m][1], b0 = acc[ai][1][m][0], b1 = acc[ai][1][m][1];
                u32x4 w; w.x = cvt_pk_bf16(silu_mul(a0[0], b0[0]), silu_mul(a0[1], b0[1])); w.y = cvt_pk_bf16(silu_mul(a0[2], b0[2]), silu_mul(a0[3], b0[3]));
                w.z = cvt_pk_bf16(silu_mul(a1[0], b1[0]), silu_mul(a1[1], b1[1])); w.w = cvt_pk_bf16(silu_mul(a1[2], b1[2]), silu_mul(a1[3], b1[3]));
                *(u32x4*)rowp = w; }
    }
};
struct EpiQKV {
    static constexpr bool PERM = true, AFTER_DRAIN = false;
    bf16_t* O; int ldc; int kind;
    const float* rope;
    const float* qg; const float* kg;
    int nq, nk;
    __device__ __forceinline__ void operator()(const f32x4 (&acc)[2][2][4][2], const Unit& u, int wr, int wc, int fr, int fq) const {
        const int hs = 4 * u.pn + wc;
        const int type = hs < nq ? 0 : (hs < nq + nk ? 1 : 2);
        const bool latent = u.pm < 128;
        const bool do_norm = (kind == 1) && (type < 2);
        const bool do_rope = (kind != 0) && (type < 2) && latent;
        const float qs = (type == 0) ? 0.125f * 1.4426950408889634f : 1.0f;
        const int half = fq >> 1, jb = 8 * (fq & 1), D0 = 32 * half + jb;
        f32x4 ga[2], gb[2];
#pragma unroll
        for (int n = 0; n < 2; ++n) { ga[n] = do_norm ? *(const f32x4*)((type == 0 ? qg : kg) + D0 + 4 * n) : (f32x4){1.f, 1.f, 1.f, 1.f};
                                      gb[n] = do_norm ? *(const f32x4*)((type == 0 ? qg : kg) + D0 + 16 + 4 * n) : (f32x4){1.f, 1.f, 1.f, 1.f}; }
#pragma unroll
        for (int ai = 0; ai < 2; ++ai)
#pragma unroll
            for (int m = 0; m < 4; ++m) {
                const int row = u.pm * BM + ai * HALF + wr * 64 + m * 16 + fr;
                f32x4 a0 = acc[ai][0][m][0], a1 = acc[ai][0][m][1], b0 = acc[ai][1][m][0], b1 = acc[ai][1][m][1];
                if (do_norm) {
                    float ss = 0.f;
#pragma unroll
                    for (int e = 0; e < 4; ++e) ss += a0[e] * a0[e] + a1[e] * a1[e] + b0[e] * b0[e] + b1[e] * b1[e];
                    ss += __shfl_xor(ss, 16); ss += __shfl_xor(ss, 32);
                    const float r = __builtin_amdgcn_rsqf(ss * (1.0f / 64.0f) + 1e-6f);
                    a0 = a0 * r * ga[0]; a1 = a1 * r * ga[1]; b0 = b0 * r * gb[0]; b1 = b1 * r * gb[1];
                }
                if (do_rope) {
                    const int s = row & 4095, pos = half ? (s & 63) : (s >> 6);
                    const f32x4 c0 = *(const f32x4*)(rope + pos * 32 + jb), c1 = *(const f32x4*)(rope + pos * 32 + jb + 4);
                    const f32x4 s0 = *(const f32x4*)(rope + pos * 32 + 16 + jb), s1 = *(const f32x4*)(rope + pos * 32 + 16 + jb + 4);
                    const f32x4 x0 = a0, x1 = a1, y0 = b0, y1 = b1;
                    a0 = x0 * c0 - y0 * s0; b0 = y0 * c0 + x0 * s0; a1 = x1 * c1 - y1 * s1; b1 = y1 * c1 + x1 * s1;
                }
                a0 = a0 * qs; a1 = a1 * qs; b0 = b0 * qs; b1 = b1 * qs;
                bf16_t* rowp = O + (size_t)row * ldc + hs * 64 + D0;
                u32x4 w;
                w.x = cvt_pk_bf16(a0[0], a0[1]); w.y = cvt_pk_bf16(a0[2], a0[3]); w.z = cvt_pk_bf16(a1[0], a1[1]); w.w = cvt_pk_bf16(a1[2], a1[3]); *(u32x4*)(rowp) = w;
                w.x = cvt_pk_bf16(b0[0], b0[1]); w.y = cvt_pk_bf16(b0[2], b0[3]); w.z = cvt_pk_bf16(b1[0], b1[1]); w.w = cvt_pk_bf16(b1[2], b1[3]); *(u32x4*)(rowp + 16) = w;
            }
    }
};

template <class Epi, class Sched, bool ALIGN_EPI = false, bool SP2 = false>
__device__ __forceinline__ void gemm_phase(PG8_LAS unsigned char* lds, const Gemm g, const Sched& S, const Epi& E, const int tid_in) {
    int tid_ = tid_in; asm volatile("" : "+v"(tid_));
    const int tid = tid_, wid = __builtin_amdgcn_readfirstlane(tid >> 6), lane = tid & 63, wr = wid >> 2, wc = wid & 3, fr = lane & 15, fq = lane >> 4;
    const int K = g.K;
    unsigned voffA[2], voffB[2];
#pragma unroll
    for (int i = 0; i < 2; ++i) { int R, C; stage_rc(tid * 16 + i * 8192, R, C); const int Rb = Epi::PERM ? ((R & ~31) + perm32(R & 31)) : R;
        voffA[i] = (unsigned)(R * K + C) * 2u; voffB[i] = (unsigned)(Rb * K + C) * 2u; }
    const size_t kstep = (size_t)(BK * 2);
    const size_t hstep = (size_t)HALF * K * 2;
    const size_t tstep = 2 * hstep;
    const unsigned ldsw = (unsigned)wid * 1024u;
    const int aoff = lds_byte(wr * 64 + fr, fq * 8), boff = lds_byte(wc * 32 + fr, fq * 8);
#define PG8_SA(b, h) (((b) * 2 + (h)) * HTB)
#define PG8_SB(b, h) ((4 + (b) * 2 + (h)) * HTB)
#define PG8_STAGE(bufoff, gbase, voff) do { _Pragma("unroll") for (int _i = 0; _i < 2; ++_i) \
        __builtin_amdgcn_global_load_lds((const unsigned*)((const char*)(gbase) + (voff)[_i]), (PG8_LAS unsigned*)(lds + (bufoff) + ldsw + _i * 8192), 16, 0, 0); } while (0)
#define PG8_LDA(dst, b, h) do { _Pragma("unroll") for (int m = 0; m < 4; ++m) _Pragma("unroll") for (int k = 0; k < 2; ++k) dst[m][k] = *(const PG8_LAS bf16x8*)(lds + PG8_SA(b, h) + aoff + m * 2048 + k * 1024); } while (0)
#define PG8_LDB(dst, b, h) do { _Pragma("unroll") for (int n = 0; n < 2; ++n) _Pragma("unroll") for (int k = 0; k < 2; ++k) dst[n][k] = *(const PG8_LAS bf16x8*)(lds + PG8_SB(b, h) + boff + n * 2048 + k * 1024); } while (0)
#define PG8_MMA(ai, bj, At, Bt) do { __builtin_amdgcn_s_setprio(1); _Pragma("unroll") for (int m = 0; m < 4; ++m) _Pragma("unroll") for (int n = 0; n < 2; ++n) _Pragma("unroll") for (int k = 0; k < 2; ++k) \
        acc[ai][bj][m][n] = __builtin_amdgcn_mfma_f32_16x16x32_bf16(Bt[n][k], At[m][k], acc[ai][bj][m][n], 0, 0, 0); __builtin_amdgcn_s_setprio(0); } while (0)
#define PG8_WAIT_V(n) asm volatile("s_waitcnt vmcnt(" #n ")" ::: "memory")
#define PG8_WAIT_L(n) asm volatile("s_waitcnt lgkmcnt(" #n ")" ::: "memory")
#define PG8_BAR __builtin_amdgcn_s_barrier()
#define PG8_SCHED __builtin_amdgcn_sched_barrier(0)
    Unit cur, nxt; int ui = 0;
    if (!S.next(0, cur)) return;
    f32x4 acc[2][2][4][2];
#pragma unroll
    for (int a = 0; a < 2; ++a)
#pragma unroll
        for (int b = 0; b < 2; ++b)
#pragma unroll
            for (int m = 0; m < 4; ++m)
#pragma unroll
                for (int n = 0; n < 2; ++n) acc[a][b][m][n] = (f32x4){0.f, 0.f, 0.f, 0.f};
    bf16x8 At[4][2], B0[2][2], B1[2][2];
    const char* cA = (const char*)g.A + (size_t)cur.pm * tstep + (size_t)cur.k0 * 2; const char* cB = (const char*)g.Bt + (size_t)cur.pn * tstep + (size_t)cur.k0 * 2;
    S.a_ready(cur);
    if constexpr (SP2) {
        PG8_STAGE(PG8_SB(0, 0), cB, voffB); PG8_STAGE(PG8_SB(0, 1), cB + hstep, voffB); PG8_STAGE(PG8_SA(0, 0), cA, voffA); PG8_STAGE(PG8_SA(0, 1), cA + hstep, voffA);
        if (wr == 1) PG8_BAR;
        PG8_WAIT_V(2); PG8_BAR;
        PG8_STAGE(PG8_SB(1, 0), cB + kstep, voffB); PG8_STAGE(PG8_SA(1, 0), cA + kstep, voffA); PG8_STAGE(PG8_SB(1, 1), cB + hstep + kstep, voffB);
        PG8_WAIT_V(6); PG8_BAR;
    } else {
        PG8_STAGE(PG8_SB(0, 0), cB, voffB); PG8_STAGE(PG8_SA(0, 0), cA, voffA); PG8_STAGE(PG8_SB(0, 1), cB + hstep, voffB); PG8_STAGE(PG8_SA(0, 1), cA + hstep, voffA);
        if (wr == 1) PG8_BAR;
        PG8_WAIT_V(4); PG8_BAR;
        PG8_STAGE(PG8_SB(1, 0), cB + kstep, voffB); PG8_STAGE(PG8_SA(1, 0), cA + kstep, voffA); PG8_STAGE(PG8_SB(1, 1), cB + hstep + kstep, voffB);
        PG8_WAIT_V(6); PG8_BAR;
    }
    for (;;) {
        const bool has_next = S.next(ui + 1, nxt);
        const char* nA = has_next ? (const char*)g.A + (size_t)nxt.pm * tstep + (size_t)nxt.k0 * 2 : cA; const char* nB = has_next ? (const char*)g.Bt + (size_t)nxt.pn * tstep + (size_t)nxt.k0 * 2 : cB;
        const int nt = cur.nt;
        for (int t = 0; t < nt; t += 2) {
            const bool last = (t == nt - 2);
            const char* a1 = cA + (size_t)(t + 1) * kstep;
            const char* a2 = last ? nA : cA + (size_t)(t + 2) * kstep; const char* b2 = last ? nB : cB + (size_t)(t + 2) * kstep;
            const char* a3 = a2 + kstep; const char* b3 = b2 + kstep;
            if (last && has_next) S.a_ready(nxt);
            if constexpr (SP2) {
            PG8_LDB(B0, 0, 0); PG8_LDB(B1, 0, 1); PG8_SCHED; PG8_LDA(At, 0, 0); PG8_STAGE(PG8_SA(1, 1), a1 + hstep, voffA);
            PG8_WAIT_V(8); PG8_WAIT_L(0); PG8_BAR; PG8_MMA(0, 0, At, B0); PG8_MMA(0, 1, At, B1); PG8_BAR; PG8_SCHED;
            PG8_LDA(At, 0, 1); PG8_STAGE(PG8_SB(0, 0), b2, voffB); PG8_STAGE(PG8_SB(0, 1), b2 + hstep, voffB); PG8_STAGE(PG8_SA(0, 0), a2, voffA);
            PG8_WAIT_V(8); PG8_WAIT_L(0); PG8_BAR; PG8_MMA(1, 0, At, B0); PG8_MMA(1, 1, At, B1); PG8_BAR; PG8_SCHED;
            PG8_LDB(B0, 1, 0); PG8_LDB(B1, 1, 1); PG8_SCHED; PG8_LDA(At, 1, 0); PG8_STAGE(PG8_SA(0, 1), a2 + hstep, voffA);
            PG8_WAIT_V(8); PG8_WAIT_L(0); PG8_BAR; PG8_MMA(0, 0, At, B0); PG8_MMA(0, 1, At, B1); PG8_BAR; PG8_SCHED;
            PG8_LDA(At, 1, 1); PG8_STAGE(PG8_SB(1, 0), b3, voffB); PG8_STAGE(PG8_SB(1, 1), b3 + hstep, voffB); PG8_STAGE(PG8_SA(1, 0), a3, voffA);
            PG8_WAIT_V(8); PG8_WAIT_L(0); PG8_BAR; PG8_MMA(1, 0, At, B0); PG8_MMA(1, 1, At, B1); PG8_BAR; PG8_SCHED;
            } else {
            PG8_LDB(B0, 0, 0); PG8_SCHED; PG8_LDA(At, 0, 0); PG8_STAGE(PG8_SA(1, 1), a1 + hstep, voffA);
            PG8_WAIT_L(8); PG8_BAR; PG8_WAIT_L(0); PG8_MMA(0, 0, At, B0); PG8_BAR; PG8_SCHED;
            PG8_LDB(B1, 0, 1); PG8_STAGE(PG8_SB(0, 0), b2, voffB);
            PG8_BAR; PG8_WAIT_L(0); PG8_MMA(0, 1, At, B1); PG8_BAR;
            PG8_LDA(At, 0, 1); PG8_STAGE(PG8_SA(0, 0), a2, voffA);
            PG8_BAR; PG8_WAIT_L(0); PG8_MMA(1, 0, At, B0); PG8_BAR; PG8_SCHED;
            PG8_STAGE(PG8_SB(0, 1), b2 + hstep, voffB);
            PG8_WAIT_V(6); PG8_BAR; PG8_MMA(1, 1, At, B1); PG8_BAR;
            PG8_LDB(B0, 1, 0); PG8_SCHED; PG8_LDA(At, 1, 0); PG8_STAGE(PG8_SA(0, 1), a2 + hstep, voffA);
            PG8_WAIT_L(8); PG8_BAR; PG8_WAIT_L(0); PG8_MMA(0, 0, At, B0); PG8_BAR; PG8_SCHED;
            PG8_LDB(B1, 1, 1); PG8_STAGE(PG8_SB(1, 0), b3, voffB);
            PG8_BAR; PG8_WAIT_L(0); PG8_MMA(0, 1, At, B1); PG8_BAR;
            PG8_LDA(At, 1, 1); PG8_STAGE(PG8_SA(1, 0), a3, voffA);
            PG8_BAR; PG8_WAIT_L(0); PG8_MMA(1, 0, At, B0); PG8_BAR; PG8_SCHED;
            PG8_STAGE(PG8_SB(1, 1), b3 + hstep, voffB);
            PG8_WAIT_V(6); PG8_BAR; PG8_MMA(1, 1, At, B1); PG8_BAR;
            }
        }
        if constexpr (ALIGN_EPI) { if (wr == 0) PG8_BAR; }
        if constexpr (!Epi::AFTER_DRAIN) { E(acc, cur, wr, wc, fr, fq); S.done(cur); }
        if (!has_next) break;
#pragma unroll
        for (int a = 0; a < 2; ++a)
#pragma unroll
            for (int b = 0; b < 2; ++b)
#pragma unroll
                for (int m = 0; m < 4; ++m)
#pragma unroll
                    for (int n = 0; n < 2; ++n) acc[a][b][m][n] = (f32x4){0.f, 0.f, 0.f, 0.f};
        cur = nxt; cA = nA; cB = nB; ++ui;
        if constexpr (ALIGN_EPI) { if (wr == 1) PG8_BAR; }
    }
    PG8_WAIT_V(0);
    if constexpr (!ALIGN_EPI) { if (wr == 0) PG8_BAR; }
    PG8_BAR;
    if constexpr (Epi::AFTER_DRAIN) { E.fused(acc, cur, wr, wc, fr, fq, lds, wid, lane); S.done(cur); }
#undef PG8_SA
#undef PG8_SB
#undef PG8_STAGE
#undef PG8_LDA
#undef PG8_LDB
#undef PG8_MMA
#undef PG8_WAIT_V
#undef PG8_WAIT_L
#undef PG8_BAR
#undef PG8_SCHED
}
}

#define LAS __attribute__((address_space(3)))
typedef pg8::bf16_t bf16_t;
typedef pg8::bf16x8 bf16x8;
typedef pg8::f32x4 f32x4;
typedef pg8::u32x4 u32x4;
typedef pg8::u32x2 u32x2;
typedef float f32x16 __attribute__((ext_vector_type(16)));
typedef short s16x4 __attribute__((ext_vector_type(4)));

constexpr int M_LAT = 32768, M_CTX = 2048, MTOT = M_LAT + M_CTX, DM = 1024, DFF = 2816, NMOD = 9;
constexpr float LOG2E = 1.4426950408889634f;
constexpr int NTHREADS = 512;
constexpr int LDS_BYTES = pg8::STAGE_BYTES + 256;
constexpr int LDS_STAGE = pg8::STAGE_BYTES;

constexpr size_t WS_ROPE = 0;
constexpr size_t WS_BAR  = 16 * 1024;
constexpr size_t WS_MOD  = 64 * 1024;
constexpr size_t WS_WIN  = 2ull * 1024 * 1024;
constexpr size_t WS_WOUT = WS_WIN + 8ull * 5632 * 1024 * 2;
constexpr size_t WS_WQKV = WS_WOUT + 8ull * 1024 * 2816 * 2;
constexpr size_t WS_WO   = WS_WQKV + 4ull * 3072 * 1024 * 2;
constexpr size_t WS_H    = WS_WO + 4ull * 1024 * 1024 * 2;
constexpr size_t WS_U    = WS_H + (size_t)MTOT * 1024 * 4;
constexpr size_t WS_R1   = WS_U + (size_t)MTOT * 1024 * 2;
constexpr size_t WS_O    = WS_R1 + (size_t)MTOT * 3072 * 2;
constexpr size_t WS_END  = WS_O + (size_t)MTOT * 1024 * 2;

struct Args { const float* in[20]; float* out; unsigned char* ws; int ph_lo, ph_hi; float lam_init; int pad; };
typedef const __attribute__((address_space(4))) Args* CArgs;

__device__ __forceinline__ float wave_sum(float v) {
#pragma unroll
    for (int o = 1; o < 64; o <<= 1) v += __shfl_xor(v, o);
    return v;
}
__device__ __forceinline__ unsigned pk2(float lo, float hi) { return pg8::cvt_pk_bf16(lo, hi); }
__device__ __forceinline__ float bf_lo(unsigned w) { return __uint_as_float(w << 16); }
__device__ __forceinline__ float bf_hi(unsigned w) { return __uint_as_float(w & 0xffff0000u); }
__device__ __forceinline__ float hf_lo(unsigned w) { return (float)__builtin_bit_cast(_Float16, (unsigned short)(w & 0xffffu)); }
__device__ __forceinline__ float hf_hi(unsigned w) { return (float)__builtin_bit_cast(_Float16, (unsigned short)(w >> 16)); }
__device__ __forceinline__ unsigned pkh2(float lo, float hi) { return (unsigned)__builtin_bit_cast(unsigned short, (_Float16)lo) | ((unsigned)__builtin_bit_cast(unsigned short, (_Float16)hi) << 16); }

__device__ __forceinline__ void transpose_item(const float* W, int K, int N, bf16_t* WT, int k0, int n0, int drow0, LAS float* scr, int lane, int hi_off = 0) {
#pragma unroll 8
    for (int i = 0; i < 32; ++i) { const int kk = 2 * i + (lane >> 5); scr[kk * 33 + (lane & 31)] = W[(size_t)(k0 + kk) * N + n0 + (lane & 31)]; }
    asm volatile("s_waitcnt lgkmcnt(0)" ::: "memory");
    const int c = lane & 7;
#pragma unroll
    for (int j = 0; j < 4; ++j) { const int n = (lane >> 3) + 8 * j; const LAS float* s = scr + (8 * c) * 33 + n;
        u32x4 o; o.x = pk2(s[0 * 33], s[1 * 33]); o.y = pk2(s[2 * 33], s[3 * 33]); o.z = pk2(s[4 * 33], s[5 * 33]); o.w = pk2(s[6 * 33], s[7 * 33]);
        *(u32x4*)(WT + (size_t)(drow0 + n + (n >= 16 ? hi_off : 0)) * K + k0 + 8 * c) = o; }
    asm volatile("s_waitcnt lgkmcnt(0)" ::: "memory");
}

__device__ __forceinline__ void prologue(CArgs a, LAS unsigned char* lds, int tid, int wid, int lane) {
    unsigned char* ws = a->ws;
    if (blockIdx.x == 0) {
        for (int i = tid; i < 1024; i += NTHREADS) { const int pos = i >> 4, j = i & 15;
            const float inv = __builtin_amdgcn_exp2f(-(float)j * (13.287712379549449f / 16.0f)); const float rev = (float)pos * inv * 0.15915494309189535f;
            float* rt = (float*)(ws + WS_ROPE) + pos * 32; rt[j] = __builtin_amdgcn_cosf(rev); rt[16 + j] = __builtin_amdgcn_sinf(rev); }
    }
    {
        LAS float* sc = (LAS float*)lds;
        LAS float* red = (LAS float*)(lds + 9 * 1024 * 4);
        for (int i = tid; i < 9 * 1024; i += NTHREADS) { const int r = i >> 10, k = i & 1023; const float v = r < 8 ? a->in[1][r * 1024 + k] : a->in[3][k];
            sc[i] = v * __builtin_amdgcn_rcpf(1.0f + __builtin_amdgcn_exp2f(-LOG2E * v)); }
        __syncthreads();
        const int cl = tid & 63, ks = tid >> 6;
        for (int item = blockIdx.x; item < 4 * 144; item += gridDim.x) {
            const int layer = item / 144, cgp = item % 144;
            const float* wp = a->in[4] + (size_t)layer * 1024 * 9216 + (size_t)(ks * 128) * 9216 + cgp * 64 + cl;
            float acc[9];
#pragma unroll
            for (int r = 0; r < 9; ++r) acc[r] = 0.f;
#pragma unroll 8
            for (int k = 0; k < 128; ++k) { const float w = wp[(size_t)k * 9216];
#pragma unroll
                for (int r = 0; r < 9; ++r) acc[r] += sc[r * 1024 + ks * 128 + k] * w; }
#pragma unroll
            for (int r = 0; r < 9; ++r) red[(ks * 9 + r) * 64 + cl] = acc[r];
            __syncthreads();
            for (int o = tid; o < 9 * 64; o += NTHREADS) { const int r = o >> 6, cc = o & 63; float s = a->in[5][layer * 9216 + cgp * 64 + cc];
#pragma unroll
                for (int q = 0; q < 8; ++q) s += red[(q * 9 + r) * 64 + cc];
                ((float*)(ws + WS_MOD))[(size_t)(layer * 9 + r) * 9216 + cgp * 64 + cc] = s; }
            __syncthreads();
        }
    }
    __syncthreads();
    {
        LAS float* scr = (LAS float*)(lds + wid * 8704);
        const int gw = blockIdx.x * 8 + wid, NGW = gridDim.x * 8;
        constexpr int I_IN = 16 * 176, I_OUT = 44 * 32, I_Q3 = 16 * 96, I_Q15 = 16 * 48, I_O = 16 * 32;
        constexpr int T_IN = 8 * I_IN, T_OUT = 8 * I_OUT, T_QKV = 3 * I_Q3 + I_Q15, T_O = 4 * I_O;
        for (int it = gw; it < T_IN + T_OUT + T_QKV + T_O; it += NGW) {
            int r = it;
            if (r < T_IN) { const int mi = r / I_IN; r %= I_IN; const int kb = r / 176, nb = r % 176, n0 = nb * 32;
                const int bj = n0 / 2816, rem = n0 % 2816, drow0 = (rem >> 7) * 256 + bj * 128 + (rem & 127);
                transpose_item(a->in[7] + (size_t)mi * 1024 * 5632, 1024, 5632, (bf16_t*)(ws + WS_WIN) + (size_t)mi * 5632 * 1024, kb * 64, n0, drow0, scr, lane); continue; }
            r -= T_IN;
            if (r < T_OUT) { const int mi = r / I_OUT; r %= I_OUT; const int kb = r / 32, nb = r % 32;
                transpose_item(a->in[8] + (size_t)mi * 2816 * 1024, 2816, 1024, (bf16_t*)(ws + WS_WOUT) + (size_t)mi * 1024 * 2816, kb * 64, nb * 32, nb * 32, scr, lane); continue; }
            r -= T_OUT;
            if (r < T_QKV) {
                int layer, N; const float* src;
                if (r < I_Q3) { layer = 0; N = 3072; src = a->in[9]; }
                else if (r < I_Q3 + I_Q15) { r -= I_Q3; layer = 1; N = 1536; src = a->in[12]; }
                else if (r < 2 * I_Q3 + I_Q15) { r -= I_Q3 + I_Q15; layer = 2; N = 3072; src = a->in[16]; }
                else { r -= 2 * I_Q3 + I_Q15; layer = 3; N = 3072; src = a->in[9] + (size_t)1024 * 3072; }
                const int nbn = N / 32, kb = r / nbn, nb = r % nbn, n0 = nb * 32, hs = n0 >> 6, half = (n0 >> 5) & 1;
                const int drow0 = (hs >> 2) * 256 + (hs & 3) * 32 + 16 * half;
                transpose_item(src, 1024, N, (bf16_t*)(ws + WS_WQKV) + (size_t)layer * 3072 * 1024, kb * 64, n0, drow0, scr, lane, 112); continue; }
            r -= T_QKV;
            { const int layer = r / I_O; r %= I_O; const int kb = r / 32, nb = r % 32;
              const float* src = layer == 0 ? a->in[11] : (layer == 1 ? a->in[15] : (layer == 2 ? a->in[19] : a->in[11] + (size_t)1024 * 1024));
              transpose_item(src, 1024, 1024, (bf16_t*)(ws + WS_WO) + (size_t)layer * 1024 * 1024, kb * 64, nb * 32, nb * 32, scr, lane); }
        }
    }
}

template <int R, bool SRCB>
__device__ __forceinline__ void norm_rows(const int row0, const int mrow, const void* hp_, bf16_t* hout, float* final_out, const bf16_t* Y, const float* YP, const float w, const float* gpost, const float* gate,
                                          bf16_t* U, const float* gpre, const float* shift, const float* scale, const int lane) {
    f32x4 h[R][2][2]; u32x4 yr[R][2];
#pragma unroll
    for (int r = 0; r < R; ++r)
#pragma unroll
        for (int j = 0; j < 2; ++j) { const int c = 8 * lane + 512 * j;
            if (SRCB) { const u32x4 t = *(const u32x4*)((const bf16_t*)hp_ + (size_t)r * DM + c);
                h[r][j][0] = (f32x4){hf_lo(t.x), hf_hi(t.x), hf_lo(t.y), hf_hi(t.y)}; h[r][j][1] = (f32x4){hf_lo(t.z), hf_hi(t.z), hf_lo(t.w), hf_hi(t.w)}; }
            else { h[r][j][0] = *(const f32x4*)((const float*)hp_ + (size_t)r * DM + c); h[r][j][1] = *(const f32x4*)((const float*)hp_ + (size_t)r * DM + c + 4); }
            if (Y) yr[r][j] = *(const u32x4*)(Y + (size_t)(row0 + r) * DM + c); }
    if (Y) {
        f32x4 gg[2][2];
#pragma unroll
        for (int j = 0; j < 2; ++j)
#pragma unroll
            for (int k = 0; k < 2; ++k) { const int c = 8 * lane + 512 * j + 4 * k; gg[j][k] = *(const f32x4*)(gpost + c) * *(const f32x4*)(gate + (size_t)mrow * 9216 + c); }
#pragma unroll
        for (int r = 0; r < R; ++r) {
            f32x4 y[2][2]; float ss = 0.f;
#pragma unroll
            for (int j = 0; j < 2; ++j) { const u32x4 t = yr[r][j];
                y[j][0] = (f32x4){bf_lo(t.x), bf_hi(t.x), bf_lo(t.y), bf_hi(t.y)}; y[j][1] = (f32x4){bf_lo(t.z), bf_hi(t.z), bf_lo(t.w), bf_hi(t.w)};
                if (R == 1 && YP) {
#pragma unroll
                    for (int k = 0; k < 2; ++k) { const float* pp = YP + (size_t)(row0 - M_LAT) * DM + 8 * lane + 512 * j + 4 * k; f32x4 s = *(const f32x4*)pp;
#pragma unroll
                        for (int q = 1; q < pg8::NSL; ++q) s = s + *(const f32x4*)(pp + (size_t)q * 2048 * DM);
                        y[j][k] = s; } }
#pragma unroll
                for (int k = 0; k < 2; ++k) ss += (y[j][k][0] * y[j][k][0] + y[j][k][1] * y[j][k][1]) + (y[j][k][2] * y[j][k][2] + y[j][k][3] * y[j][k][3]); }
            const float rr = __builtin_amdgcn_rsqf(wave_sum(ss) * (1.0f / DM) + 1e-6f) * w;
#pragma unroll
            for (int j = 0; j < 2; ++j)
#pragma unroll
                for (int k = 0; k < 2; ++k) h[r][j][k] = h[r][j][k] + gg[j][k] * (y[j][k] * rr);
        }
    }
#pragma unroll
    for (int r = 0; r < R; ++r)
#pragma unroll
        for (int j = 0; j < 2; ++j) { const int c = 8 * lane + 512 * j;
            if (final_out) { *(f32x4*)(final_out + (size_t)(row0 + r) * DM + c) = h[r][j][0]; *(f32x4*)(final_out + (size_t)(row0 + r) * DM + c + 4) = h[r][j][1]; }
            else { u32x4 t; t.x = pkh2(h[r][j][0][0], h[r][j][0][1]); t.y = pkh2(h[r][j][0][2], h[r][j][0][3]); t.z = pkh2(h[r][j][1][0], h[r][j][1][1]); t.w = pkh2(h[r][j][1][2], h[r][j][1][3]);
                *(u32x4*)(hout + (size_t)(row0 + r) * DM + c) = t; } }
    if (U) {
        f32x4 gp[2][2], sc1[2][2], sh[2][2];
#pragma unroll
        for (int j = 0; j < 2; ++j)
#pragma unroll
            for (int k = 0; k < 2; ++k) { const int c = 8 * lane + 512 * j + 4 * k; gp[j][k] = *(const f32x4*)(gpre + c); sc1[j][k] = *(const f32x4*)(scale + (size_t)mrow * 9216 + c) + 1.0f; sh[j][k] = *(const f32x4*)(shift + (size_t)mrow * 9216 + c); }
#pragma unroll
        for (int r = 0; r < R; ++r) {
            float ss = 0.f;
#pragma unroll
            for (int j = 0; j < 2; ++j)
#pragma unroll
                for (int k = 0; k < 2; ++k) ss += (h[r][j][k][0] * h[r][j][k][0] + h[r][j][k][1] * h[r][j][k][1]) + (h[r][j][k][2] * h[r][j][k][2] + h[r][j][k][3] * h[r][j][k][3]);
            const float rr = __builtin_amdgcn_rsqf(wave_sum(ss) * (1.0f / DM) + 1e-6f);
#pragma unroll
            for (int j = 0; j < 2; ++j) { const f32x4 v0 = (h[r][j][0] * rr * gp[j][0]) * sc1[j][0] + sh[j][0], v1 = (h[r][j][1] * rr * gp[j][1]) * sc1[j][1] + sh[j][1];
                u32x4 t; t.x = pk2(v0[0], v0[1]); t.y = pk2(v0[2], v0[3]); t.z = pk2(v1[0], v1[1]); t.w = pk2(v1[2], v1[3]);
                *(u32x4*)(U + (size_t)(row0 + r) * DM + 8 * lane + 512 * j) = t; }
        }
    }
}
template <bool SRCB>
__device__ __forceinline__ void norm_phase(const void* hsrc_lat, const void* hsrc_ctx, bf16_t* hout, float* final_out, const bf16_t* Y, const float* YP, float w, const float* gpost, const float* gate,
                                           bf16_t* U, const float* gpre, const float* shift, const float* scale, const bool with_ctx, int wid, int lane) {
    const int gw = blockIdx.x * 8 + wid, NGW = gridDim.x * 8;
    for (int g = gw; g < M_LAT / 4; g += NGW) norm_rows<4, SRCB>(4 * g, g >> 10, SRCB ? (const void*)((const bf16_t*)hsrc_lat + (size_t)g * 4 * DM) : (const void*)((const float*)hsrc_lat + (size_t)g * 4 * DM), hout, final_out, Y, nullptr, w, gpost, gate, U, gpre, shift, scale, lane);
    if (with_ctx) for (int row = M_LAT + gw; row < MTOT; row += NGW) norm_rows<1, SRCB>(row, 8, SRCB ? (const void*)((const bf16_t*)hsrc_ctx + (size_t)(row - M_LAT) * DM) : (const void*)((const float*)hsrc_ctx + (size_t)(row - M_LAT) * DM), hout, final_out, Y, YP, w, gpost, gate, U, gpre, shift, scale, lane);
}

__device__ __forceinline__ int crow(int r, int hi) { return (r & 3) + 8 * (r >> 2) + 4 * hi; }
typedef float f32x2_t __attribute__((ext_vector_type(2)));
typedef __bf16 bf16x2_t __attribute__((ext_vector_type(2)));
__device__ __forceinline__ unsigned pk2n(float lo, float hi) { const f32x2_t v = {lo, hi}; return __builtin_bit_cast(unsigned, __builtin_convertvector(v, bf16x2_t)); }
__device__ __forceinline__ float max3f(float a, float b, float c) { float d; asm("v_max3_f32 %0, %1, %2, %3" : "=v"(d) : "v"(a), "v"(b), "v"(c)); return d; }

template <int KIND>
__device__ __forceinline__ void attn_phase(LAS unsigned char* lds, const bf16_t* qkv, const int N, bf16_t* O, const float* rpb, const float* lam, const float* subg, const float lam_init,
                                           const bool do_ctx, const int tid, const int wid, const int lane) {
    constexpr int HDV = KIND == 2 ? 128 : 64, NK = KIND == 2 ? 2 : 1, NDT = HDV / 32, NVC = HDV / 64;
    constexpr int KSTR = 144, VSTR = HDV * 2 + 64, KT = 64 * KSTR, KBUF = NK * KT, VBUF = 64 * VSTR;
    constexpr int OFF_V = 2 * KBUF, OFF_BIAS = OFF_V + 2 * VBUF;
    constexpr int QW = KIND == 2 ? 128 : 256;
    constexpr int SROW = HDV * 2 + 16, STG_OFF = KIND == 2 ? 81920 : 49152;
    static_assert(OFF_BIAS + 2048 <= STG_OFF && STG_OFF + (KIND == 2 ? 4 : 8) * 32 * SROW <= LDS_STAGE, "attention LDS map");
    const int l32 = lane & 31, hi = lane >> 5;
    float lam_full = 0.f;
    if (KIND == 2) { const float s01 = wave_sum(lam[lane] * lam[64 + lane]), s23 = wave_sum(lam[128 + lane] * lam[192 + lane]);
        lam_full = __builtin_amdgcn_exp2f(s01 * LOG2E) - __builtin_amdgcn_exp2f(s23 * LOG2E) + lam_init; }
    if (wid >= 4) __builtin_amdgcn_s_setprio(1);
    const int n_units = 2048 + (do_ctx ? 128 : 0);
    for (int u = blockIdx.x; u < n_units; u += gridDim.x) {
        const bool isctx = u >= 2048; const int uu = isctx ? u - 2048 : u;
        int b, h, qb;
        const int xw = uu & 7, jw = (uu >> 3) & 31;
        if (KIND == 2) { if (!isctx) { qb = jw; h = xw; b = uu >> 8; } else { qb = uu & 1; h = (uu >> 1) & 7; b = uu >> 4; } }
        else if (KIND == 1) { if (!isctx) { const int item = (xw >> 2) * 32 + jw; qb = item & 15; h = (xw & 3) * 4 + (item >> 4); b = uu >> 8; } else { qb = 0; h = uu & 15; b = uu >> 4; } }
        else           { if (!isctx) { qb = jw & 15; h = xw + 8 * (jw >> 4); b = uu >> 8; } else { qb = 0; h = uu & 15; b = uu >> 4; } }
        const int qrow0 = isctx ? M_LAT + b * 256 + qb * QW : b * 4096 + qb * QW;
        int qoff, hq, kidx;
        if (KIND == 2) { const int i = wid >> 2; qoff = 32 * (wid & 3); hq = i * 8 + h; kidx = i; } else { qoff = 32 * wid; hq = h; kidx = 0; }
        const int kcol0 = KIND == 1 ? 1024 + (h >> 2) * 64 : 1024 + h * 64;
        const int vcol = KIND == 0 ? 2048 + h * 64 : (KIND == 1 ? 1280 + (h >> 2) * 64 : 2048 + h * 128);
        int base1 = b * 4096, n1 = 64, kr_lo = 0, rs_w = 0, qr = 0, qc = 0, cs = 0;
        if (KIND == 0) { const int r0 = qb * 4; kr_lo = min(max(r0 - 4, 0), 56); const int kr_hi = min(max(r0 - 1, 0), 56) + 8; base1 += kr_lo * 64; n1 = kr_hi - kr_lo;
            qr = r0 + (wid >> 1); rs_w = min(max(qr - 4, 0), 56); qc = 32 * (wid & 1) + l32; cs = min(max(qc - 8, 0), 48); }
        if (isctx) n1 = 0;
        const int base2 = M_LAT + b * 256, nt = n1 + 4;

        bf16x8 qf[4];
        { const bf16_t* qp = qkv + (size_t)(qrow0 + qoff + l32) * N + hq * 64 + 8 * hi;
#pragma unroll
          for (int t = 0; t < 4; ++t) qf[t] = *(const bf16x8*)(qp + 16 * t); }
        if (KIND == 0 && !isctx) { LAS float* bt = (LAS float*)(lds + OFF_BIAS); for (int i = tid; i < 465; i += NTHREADS) bt[i] = rpb[h * 465 + i] * LOG2E; }

        u32x4 kreg[NK], vreg[NVC];
        const int krow_l = tid >> 3, kpart = tid & 7;
#define ATT_LOAD(T) do { const int _t = (T); const int _rb = _t < n1 ? base1 + 64 * _t : base2 + 64 * (_t - n1); \
            _Pragma("unroll") for (int _c = 0; _c < NK; ++_c) kreg[_c] = *(const u32x4*)(qkv + (size_t)(_rb + krow_l) * N + kcol0 + _c * 512 + kpart * 8); \
            _Pragma("unroll") for (int _c = 0; _c < NVC; ++_c) { const int _ch = tid + _c * 512; const int _vr = _ch / (HDV / 8), _vp = _ch % (HDV / 8); \
                vreg[_c] = *(const u32x4*)(qkv + (size_t)(_rb + _vr) * N + vcol + _vp * 8); } } while (0)
#define ATT_STORE(B) do { const int _b = (B); \
            _Pragma("unroll") for (int _c = 0; _c < NK; ++_c) *(LAS u32x4*)(lds + _b * KBUF + _c * KT + krow_l * KSTR + kpart * 16) = kreg[_c]; \
            _Pragma("unroll") for (int _c = 0; _c < NVC; ++_c) { const int _ch = tid + _c * 512; const int _vr = _ch / (HDV / 8), _vp = _ch % (HDV / 8); \
                *(LAS u32x4*)(lds + OFF_V + _b * VBUF + _vr * VSTR + _vp * 16) = vreg[_c]; } } while (0)

        float m_ref = 0.f; int first = 1;
        f32x16 o[NDT], lacc, mneg;
#pragma unroll
        for (int dt = 0; dt < NDT; ++dt)
#pragma unroll
            for (int j = 0; j < 16; ++j) o[dt][j] = 0.f;
#pragma unroll
        for (int j = 0; j < 16; ++j) { lacc[j] = 0.f; mneg[j] = 0.f; }
        const bf16x8 ones = {(short)0x3F80, (short)0x3F80, (short)0x3F80, (short)0x3F80, (short)0x3F80, (short)0x3F80, (short)0x3F80, (short)0x3F80};

        ATT_LOAD(0); ATT_STORE(0); __syncthreads();
        const int koff = kidx * KT + l32 * KSTR + 16 * hi;
        const int voff = OFF_V + (4 * hi + ((lane & 15) >> 2)) * VSTR + (16 * ((lane >> 4) & 1) + 4 * (lane & 3)) * 2;
        const int wb = 4 * hi - cs;
        const int boff0 = OFF_BIAS + 4 * (cs - qc + 15 + wb);
        for (int t = 0; t < nt; ++t) {
            if (t + 1 < nt) ATT_LOAD(t + 1);
            bool active = true;
            if (KIND == 0 && t < n1) { const int kr = kr_lo + t; active = (kr >= rs_w) && (kr < rs_w + 8); }
            if (__builtin_amdgcn_readfirstlane((int)active)) {
                const int buf = t & 1;
                bf16x8 kf[8];
#pragma unroll
                for (int t4 = 0; t4 < 4; ++t4) { kf[2 * t4] = *(const LAS bf16x8*)(lds + buf * KBUF + koff + 32 * t4); kf[2 * t4 + 1] = *(const LAS bf16x8*)(lds + buf * KBUF + koff + 32 * KSTR + 32 * t4); }
                __builtin_amdgcn_sched_barrier(0);
                f32x16 s0, s1;
#pragma unroll
                for (int t4 = 0; t4 < 4; ++t4) {
                    s0 = __builtin_amdgcn_mfma_f32_32x32x16_bf16(kf[2 * t4], qf[t4], t4 == 0 ? mneg : s0, 0, 0, 0);
                    s1 = __builtin_amdgcn_mfma_f32_32x32x16_bf16(kf[2 * t4 + 1], qf[t4], t4 == 0 ? mneg : s1, 0, 0, 0);
                }
                float ab0[16], ab1[16];
                const bool na_lat = (KIND == 0) && (t < n1);
                if (na_lat) {
                    const int bo = boff0 + (kr_lo + t - qr + 7) * 124;
#pragma unroll
                    for (int j = 0; j < 16; ++j) {
                        const int C0 = 8 * (j >> 2) + (j & 3), C1 = 32 + C0;
                        const float b0 = *(const LAS float*)(lds + bo + 4 * C0), b1 = *(const LAS float*)(lds + bo + 4 * C1);
                        ab0[j] = ((unsigned)(wb + C0) < 16u) ? b0 : -1e30f;
                        ab1[j] = ((unsigned)(wb + C1) < 16u) ? b1 : -1e30f;
                    }
#pragma unroll
                    for (int i = 0; i < 8; ++i) { __builtin_amdgcn_sched_group_barrier(0x008, 1, 0); __builtin_amdgcn_sched_group_barrier(0x100, 4, 0); __builtin_amdgcn_sched_group_barrier(0x002, 6, 0); }
                }
                __builtin_amdgcn_sched_barrier(0);
                s16x4 vfa[2][NDT][2], vfb[2][NDT][2];
#pragma unroll
                for (int s = 0; s < 2; ++s)
#pragma unroll
                    for (int dt = 0; dt < NDT; ++dt) {
                        vfa[s][dt][0] = __builtin_amdgcn_ds_read_tr16_b64_v4i16((LAS s16x4*)(lds + buf * VBUF + voff + (16 * s) * VSTR + 64 * dt));
                        vfa[s][dt][1] = __builtin_amdgcn_ds_read_tr16_b64_v4i16((LAS s16x4*)(lds + buf * VBUF + voff + (16 * s + 8) * VSTR + 64 * dt)); }
                __builtin_amdgcn_sched_barrier(0);
                if (na_lat) {
#pragma unroll
                    for (int j = 0; j < 16; ++j) { s0[j] += ab0[j]; s1[j] += ab1[j]; }
                }
                const float mx0 = fmaxf(s1[15], s0[15]);
                float mxa = max3f(mx0, s0[0], s1[0]), mxb = max3f(mx0, s0[1], s1[1]);
#pragma unroll
                for (int j = 2; j < 15; j += 2) { mxa = max3f(mxa, s0[j], s1[j]); mxb = max3f(mxb, s0[j + 1], s1[j + 1]); }
                float mx = fmaxf(mxa, mxb);
                if (first || __builtin_amdgcn_ballot_w64(mx > 8.0f) != 0ull) {
                    mx = fmaxf(mx, __shfl_xor(mx, 32));
                    const float d = first ? mx : fmaxf(mx, 0.f);
                    const float alpha = first ? 1.0f : __builtin_amdgcn_exp2f(-d);
                    m_ref += d;
#pragma unroll
                    for (int j = 0; j < 16; ++j) { mneg[j] -= d; s0[j] -= d; s1[j] -= d; lacc[j] *= alpha; }
#pragma unroll
                    for (int dt = 0; dt < NDT; ++dt)
#pragma unroll
                        for (int j = 0; j < 16; ++j) o[dt][j] *= alpha;
                    first = 0;
                }
#pragma unroll
                for (int j = 0; j < 16; ++j) s0[j] = __builtin_amdgcn_exp2f(s0[j]);
                bf16x8 pf[4];
#pragma unroll
                for (int s = 0; s < 2; ++s) { u32x4 w; w.x = pk2n(s0[8 * s + 0], s0[8 * s + 1]); w.y = pk2n(s0[8 * s + 2], s0[8 * s + 3]); w.z = pk2n(s0[8 * s + 4], s0[8 * s + 5]); w.w = pk2n(s0[8 * s + 6], s0[8 * s + 7]);
                    pf[s] = __builtin_bit_cast(bf16x8, w); }
                __builtin_amdgcn_sched_barrier(0);
#pragma unroll
                for (int s = 0; s < 2; ++s)
#pragma unroll
                    for (int dt = 0; dt < NDT; ++dt) {
                        vfb[s][dt][0] = __builtin_amdgcn_ds_read_tr16_b64_v4i16((LAS s16x4*)(lds + buf * VBUF + voff + (16 * (s + 2)) * VSTR + 64 * dt));
                        vfb[s][dt][1] = __builtin_amdgcn_ds_read_tr16_b64_v4i16((LAS s16x4*)(lds + buf * VBUF + voff + (16 * (s + 2) + 8) * VSTR + 64 * dt)); }
                {
                    constexpr int NM = 2 * (1 + NDT);
                    int mi = 0;
#pragma unroll
                    for (int s = 0; s < 2; ++s) {
                        lacc = __builtin_amdgcn_mfma_f32_32x32x16_bf16(ones, pf[s], lacc, 0, 0, 0);
#pragma unroll
                        for (int j = (mi * 16) / NM; j < ((mi + 1) * 16) / NM; ++j) s1[j] = __builtin_amdgcn_exp2f(s1[j]);
                        ++mi;
#pragma unroll
                        for (int dt = 0; dt < NDT; ++dt) {
                            const s16x4 va = vfa[s][dt][0], vb = vfa[s][dt][1];
                            const bf16x8 vf = {va[0], va[1], va[2], va[3], vb[0], vb[1], vb[2], vb[3]};
                            o[dt] = __builtin_amdgcn_mfma_f32_32x32x16_bf16(vf, pf[s], o[dt], 0, 0, 0);
#pragma unroll
                            for (int j = (mi * 16) / NM; j < ((mi + 1) * 16) / NM; ++j) s1[j] = __builtin_amdgcn_exp2f(s1[j]);
                            ++mi;
                        }
                    }
#pragma unroll
                    for (int q = 0; q < 2; ++q) { u32x4 w; w.x = pk2n(s1[8 * q + 0], s1[8 * q + 1]); w.y = pk2n(s1[8 * q + 2], s1[8 * q + 3]); w.z = pk2n(s1[8 * q + 4], s1[8 * q + 5]); w.w = pk2n(s1[8 * q + 6], s1[8 * q + 7]);
                        pf[q + 2] = __builtin_bit_cast(bf16x8, w); }
#pragma unroll
                    for (int i = 0; i < NM; ++i) { __builtin_amdgcn_sched_group_barrier(0x008, 1, 0); __builtin_amdgcn_sched_group_barrier(0x402, (16 + NM - 1) / NM + 1, 0); }
                }
                __builtin_amdgcn_sched_barrier(0);
#pragma unroll
                for (int s = 0; s < 2; ++s) {
                    lacc = __builtin_amdgcn_mfma_f32_32x32x16_bf16(ones, pf[s + 2], lacc, 0, 0, 0);
#pragma unroll
                    for (int dt = 0; dt < NDT; ++dt) {
                        const s16x4 va = vfb[s][dt][0], vb = vfb[s][dt][1];
                        const bf16x8 vf = {va[0], va[1], va[2], va[3], vb[0], vb[1], vb[2], vb[3]};
                        o[dt] = __builtin_amdgcn_mfma_f32_32x32x16_bf16(vf, pf[s + 2], o[dt], 0, 0, 0);
                    }
                }
                __builtin_amdgcn_sched_barrier(0);
            }
            if (t + 1 < nt) ATT_STORE((t + 1) & 1);
            __syncthreads();
        }
#undef ATT_LOAD
#undef ATT_STORE
        const float l_tot = lacc[0];
        const float inv = 1.0f / l_tot;
        int lane_e = lane; asm volatile("" : "+v"(lane_e));
        const int l32e = lane_e & 31, hie = lane_e >> 5;
        const int orow = qrow0 + qoff + l32e;
        if (KIND != 2) {
            LAS unsigned char* stg = lds + STG_OFF + wid * (32 * SROW);
#pragma unroll
            for (int dt = 0; dt < NDT; ++dt)
#pragma unroll
                for (int g = 0; g < 4; ++g) { u32x2 w; w.x = pk2(o[dt][4 * g] * inv, o[dt][4 * g + 1] * inv); w.y = pk2(o[dt][4 * g + 2] * inv, o[dt][4 * g + 3] * inv);
                    *(LAS u32x2*)(stg + l32e * SROW + (32 * dt + 8 * g + 4 * hie) * 2) = w; }
            bf16_t* ob = O + (size_t)(qrow0 + qoff) * DM + hq * 64;
#pragma unroll
            for (int i = 0; i < 4; ++i) { const int c = lane_e + 64 * i, row = c >> 3, part = c & 7;
                const u32x4 v = *(const LAS u32x4*)(stg + row * SROW + part * 16);
                *(u32x4*)(ob + (size_t)row * DM + part * 8) = v; }
        } else {
            LAS float* cb = (LAS float*)lds + (size_t)(wid & 3) * (64 * 64) + lane_e;
            if (wid >= 4) {
#pragma unroll
                for (int dt = 0; dt < NDT; ++dt)
#pragma unroll
                    for (int j = 0; j < 16; ++j) cb[(dt * 16 + j) * 64] = o[dt][j] * inv;
            }
            __syncthreads();
            if (wid < 4) {
                float ss = 0.f;
#pragma unroll
                for (int dt = 0; dt < NDT; ++dt)
#pragma unroll
                    for (int j = 0; j < 16; ++j) { const float v = o[dt][j] * inv - lam_full * cb[(dt * 16 + j) * 64]; o[dt][j] = v; ss += v * v; }
                ss += __shfl_xor(ss, 32);
                float li_ = lam_init; asm volatile("" : "+v"(li_));
                const float r = __builtin_amdgcn_rsqf(ss * (1.0f / 128.0f) + 1e-6f) * (1.0f - li_);
                LAS unsigned char* stg = lds + STG_OFF + (wid & 3) * (32 * SROW);
#pragma unroll
                for (int dt = 0; dt < NDT; ++dt)
#pragma unroll
                    for (int g = 0; g < 4; ++g) { const f32x4 sg = *(const f32x4*)(subg + 32 * dt + 8 * g + 4 * hie);
                        u32x2 w; w.x = pk2(o[dt][4 * g] * r * sg[0], o[dt][4 * g + 1] * r * sg[1]); w.y = pk2(o[dt][4 * g + 2] * r * sg[2], o[dt][4 * g + 3] * r * sg[3]);
                        *(LAS u32x2*)(stg + l32e * SROW + (32 * dt + 8 * g + 4 * hie) * 2) = w; }
                bf16_t* ob = O + (size_t)(qrow0 + qoff) * DM + h * 128;
#pragma unroll
                for (int i = 0; i < 8; ++i) { const int c = lane_e + 64 * i, row = c >> 4, part = c & 15;
                    const u32x4 v = *(const LAS u32x4*)(stg + row * SROW + part * 16);
                    *(u32x4*)(ob + (size_t)row * DM + part * 8) = v; }
            }
            __syncthreads();
        }
    }
    __builtin_amdgcn_s_setprio(0);
}

#define XB_TMO      128
#define XB_XCNT(j)  (256  + 64 * (j))
#define XB_XSUB(j)  (1280 + 64 * (j))
#define XB_XGEN(j)  (2304 + 64 * (j))
#define XB_TOP      3328
#define XB_TOPGEN   3392
#define XCD_BAR_WORDS 3456
#define XB_SPIN_CAP (1u << 18)

__device__ __forceinline__ unsigned xb_ld(unsigned* p)              { return __hip_atomic_load(p, __ATOMIC_RELAXED, __HIP_MEMORY_SCOPE_AGENT); }
__device__ __forceinline__ unsigned xb_add(unsigned* p, unsigned v) { return __hip_atomic_fetch_add(p, v, __ATOMIC_RELAXED, __HIP_MEMORY_SCOPE_AGENT); }
__device__ __forceinline__ unsigned xb_xcc_id() { return (unsigned)__builtin_amdgcn_s_getreg((3 << 11) | 20) & 0xFu; }
#define XB_SPIN(cond, bar) do { unsigned _sp = 0; while (cond) { __builtin_amdgcn_s_sleep(1); \
    if ((++_sp & 255u) == 0u) { if (xb_ld(&(bar)[XB_TMO])) break; if (_sp > XB_SPIN_CAP) { atomicAdd(&(bar)[XB_TMO], 1u); break; } } } } while (0)

struct XcdBarrier {
    unsigned* bar; unsigned x;
    volatile LAS unsigned* st;
};

__device__ __forceinline__ XcdBarrier xcd_barrier_post(unsigned* bar, volatile LAS unsigned* st) {
    XcdBarrier b; b.bar = bar; b.x = xb_xcc_id(); b.st = st;
    if (threadIdx.x == 0) (void)xb_add(&bar[XB_XCNT(b.x)], 1u);
    return b;
}
__device__ __forceinline__ void xcd_barrier_complete(unsigned* bar, unsigned x, unsigned& nloc, unsigned& nx) {
    const unsigned G = gridDim.x * gridDim.y * gridDim.z;
    unsigned sum, cnt, mine, sp = 0u;
    for (;;) {
        sum = 0u; cnt = 0u; mine = 0u;
#pragma unroll
        for (unsigned j = 0; j < 16; ++j) { const unsigned c = xb_ld(&bar[XB_XCNT(j)]); sum += c; cnt += (c > 0u) ? 1u : 0u; mine = (j == x) ? c : mine; }
        if (sum == G) break;
        __builtin_amdgcn_s_sleep(1);
        if ((++sp & 255u) == 0u) { if (xb_ld(&bar[XB_TMO])) break; if (sp > XB_SPIN_CAP) { atomicAdd(&bar[XB_TMO], 1u); break; } }
    }
    nloc = mine > 0u ? mine : 1u; nx = cnt > 0u ? cnt : 1u;
}

__device__ __forceinline__ void xcd_barrier(const XcdBarrier& b) {
    asm volatile("s_waitcnt vmcnt(0)" ::: "memory");
    __syncthreads();
    if (threadIdx.x == 0) {
        unsigned* bar = b.bar;
        __builtin_amdgcn_s_waitcnt(0);
        unsigned nloc = b.st[0], nx = b.st[1];
        if (nloc == 0u) { xcd_barrier_complete(bar, b.x, nloc, nx); b.st[0] = nloc; b.st[1] = nx; }
        const unsigned old = xb_add(&bar[XB_XSUB(b.x)], 1u);
        const unsigned gen = old / nloc;
        if (old + 1u == (gen + 1u) * nloc) {
            __builtin_amdgcn_fence(__ATOMIC_RELEASE, "agent");
            asm volatile("s_waitcnt vmcnt(0)" ::: "memory");
            const unsigned og = xb_add(&bar[XB_TOP], 1u);
            const unsigned tg = og / nx;
            if (og + 1u == (tg + 1u) * nx) xb_add(&bar[XB_TOPGEN], 1u);
            else XB_SPIN(xb_ld(&bar[XB_TOPGEN]) == tg, bar);
            __builtin_amdgcn_fence(__ATOMIC_ACQUIRE, "agent");
            xb_add(&bar[XB_XGEN(b.x)], 1u);
            asm volatile("s_waitcnt vmcnt(0)" ::: "memory");
        } else {
            XB_SPIN(xb_ld(&bar[XB_XGEN(b.x)]) == gen, bar);
            __builtin_amdgcn_fence(__ATOMIC_ACQUIRE, "agent");
            asm volatile("s_waitcnt vmcnt(0)" ::: "memory");
        }
    }
    __syncthreads();
}

#ifndef EN
#define EN 511
#endif
#ifndef REP_GEMM
#define REP_GEMM 1
#endif
#ifndef REP_MASK
#define REP_MASK 0x3ff
#endif
#ifndef REP_NORM
#define REP_NORM 1
#endif
#ifndef REP_ATT
#define REP_ATT 1
#endif
#ifndef EXTRA_SYNC
#define EXTRA_SYNC 0
#endif
#ifndef REP_PRO
#define REP_PRO 1
#endif
__global__ void __launch_bounds__(NTHREADS, 2) mega_fwd(Args a_unused) {
    CArgs a = (CArgs)__builtin_amdgcn_kernarg_segment_ptr();
    extern __shared__ __attribute__((aligned(16))) unsigned char lds_raw[];
    LAS unsigned char* lds = (LAS unsigned char*)lds_raw;
    cg::grid_group grid = cg::this_grid();
    const int wid0 = __builtin_amdgcn_readfirstlane((int)(threadIdx.x >> 6));
    volatile LAS unsigned* xst = (volatile LAS unsigned*)(lds + LDS_STAGE);
    if (threadIdx.x < 2) xst[threadIdx.x] = 0u;
    unsigned* barw = (unsigned*)(a->ws + WS_BAR);
    if (blockIdx.x == 0) for (int i = threadIdx.x; i < XCD_BAR_WORDS; i += NTHREADS) __hip_atomic_store(barw + i, 0u, __ATOMIC_RELAXED, __HIP_MEMORY_SCOPE_AGENT);
    __syncthreads();
    XcdBarrier bar; bar.bar = barw; bar.x = 0; bar.st = xst;
    int rep_left = -1;
    for (int ph = a->ph_lo; ph < a->ph_hi; ++ph) {
        asm volatile("" : "+s"(a));
        int lane_ = (int)__builtin_amdgcn_mbcnt_hi(~0u, __builtin_amdgcn_mbcnt_lo(~0u, 0u)); asm volatile("" : "+v"(lane_));
        int wid_ = wid0; asm volatile("" : "+s"(wid_));
        const int lane = lane_, wid = wid_, tid = wid * 64 + lane;
        unsigned char* ws = a->ws;
        bf16_t* H = (bf16_t*)(ws + WS_H); bf16_t* U = (bf16_t*)(ws + WS_U); bf16_t* ACT = (bf16_t*)(ws + WS_R1); bf16_t* QKV = (bf16_t*)(ws + WS_R1); bf16_t* OB = (bf16_t*)(ws + WS_O);
        const float* MOD = (const float*)(ws + WS_MOD); const float* ROPE = (const float*)(ws + WS_ROPE);
        const float* NG = a->in[6];
        if (ph == 0) { if (EN & 1) prologue(a, lds, tid, wid, lane); }
        else if (ph == 1) { if (EN & 2) norm_phase<false>(a->in[0], a->in[2], H, nullptr, nullptr, nullptr, 0.f, nullptr, nullptr, U, NG, MOD + 0 * 1024, MOD + 1 * 1024, true, wid, lane); }
        else {
            const int L = (ph - 2) / 10, st = (ph - 2) % 10;
            const float* modL = MOD + (size_t)L * 9 * 9216; const float* ngL = NG + (size_t)L * 6 * 1024;
            const int kind = L % 3;
            if (st == 0 || st == 7) {
                const int f = st == 0 ? 0 : 1;
                const int Mr = (L == 3 && f == 1) ? M_LAT : MTOT;
                pg8::Gemm g{U, (const bf16_t*)(ws + WS_WIN) + (size_t)(L * 2 + f) * 5632 * 1024, Mr, 5632, 1024}; pg8::StaticOrder S; S.init(Mr, 5632, (int)gridDim.x, (int)blockIdx.x, 1024);
                pg8::EpiSwiglu E{ACT, DFF};
                if (EN & 4) pg8::gemm_phase<pg8::EpiSwiglu, pg8::StaticOrder, true, true>(lds, g, S, E, tid);
            } else if (st == 1 || st == 8 || st == 5) {
                const int f = st == 1 ? 0 : 1;
                const bf16_t* A = st == 5 ? OB : ACT; const int K = st == 5 ? 1024 : DFF;
                const bf16_t* Bt = st == 5 ? (const bf16_t*)(ws + WS_WO) + (size_t)L * 1024 * 1024 : (const bf16_t*)(ws + WS_WOUT) + (size_t)(L * 2 + f) * 1024 * 2816;
                const bool wctx = !(L == 3 && st != 1);
                float* YP = (float*)(ws + WS_R1 + (st == 5 ? 0ull : 200ull * 1024 * 1024));
                pg8::Gemm g{A, Bt, MTOT, 1024, K}; pg8::SplitOrder S; S.init(M_LAT, 1024, (int)gridDim.x, (int)blockIdx.x, K, wctx);
                pg8::EpiPlain E{U, DM, YP, M_LAT};
                if (EN & 8) pg8::gemm_phase<pg8::EpiPlain, pg8::SplitOrder, true, true>(lds, g, S, E, tid);
            } else if (st == 3) {
                const int N = kind == 1 ? 1536 : 3072;
                pg8::Gemm g{U, (const bf16_t*)(ws + WS_WQKV) + (size_t)L * 3072 * 1024, MTOT, N, 1024}; pg8::StaticOrder S; S.init(MTOT, N, (int)gridDim.x, (int)blockIdx.x, 1024);
                pg8::EpiQKV E{QKV, N, kind, ROPE, a->in[13], a->in[14], 16, kind == 1 ? 4 : 16};
                if (EN & 16) pg8::gemm_phase<pg8::EpiQKV, pg8::StaticOrder, true, true>(lds, g, S, E, tid);
            } else if (st == 4) {
                const bool do_ctx = L < 3;
                if (kind == 0) { if (EN & 32) attn_phase<0>(lds, QKV, 3072, OB, a->in[10] + (size_t)(L / 3) * 16 * 465, nullptr, nullptr, 0.f, do_ctx, tid, wid, lane); }
                else if (kind == 1) { if (EN & 64) attn_phase<1>(lds, QKV, 1536, OB, nullptr, nullptr, nullptr, 0.f, do_ctx, tid, wid, lane); }
                else { if (EN & 128) attn_phase<2>(lds, QKV, 3072, OB, nullptr, a->in[17], a->in[18], a->lam_init, do_ctx, tid, wid, lane); }
            } else {
                const float w = st == 6 ? 1.0f : 0.5f;
                const int gi = st == 2 ? 1 : (st == 6 ? 3 : 5), gk = st == 2 ? 2 : (st == 6 ? 5 : 8);
                const bool fin = (st == 9 && L == 3);
                const float* gpre; const float* shift; const float* scale;
                if (st == 2) { gpre = ngL + 2 * 1024; shift = modL + 3 * 1024; scale = modL + 4 * 1024; }
                else if (st == 6) { gpre = ngL + 4 * 1024; shift = modL + 6 * 1024; scale = modL + 7 * 1024; }
                else { gpre = ngL + 6 * 1024; shift = modL + 9 * 9216; scale = modL + 9 * 9216 + 1024; }
#if REP_NORM > 1
                if (!fin) norm_phase<true>(H, H + (size_t)M_LAT * DM, (bf16_t*)(ws + WS_R1), nullptr, U, nullptr, w, ngL + gi * 1024, modL + gk * 1024, (bf16_t*)(ws + WS_R1 + 160ull * 1024 * 1024), gpre, shift, scale, !(L == 3 && st >= 6), wid, lane);
                __syncthreads();
#endif
                if (EN & 256) norm_phase<true>(H, H + (size_t)M_LAT * DM, H, fin ? a->out : nullptr, U, (const float*)(ws + WS_R1 + (st == 6 ? 0ull : 200ull * 1024 * 1024)), w, ngL + gi * 1024, modL + gk * 1024, fin ? nullptr : U, gpre, shift, scale, !(L == 3 && st >= 6), wid, lane);
            }
        }
#if REP_GEMM > 1 || REP_ATT > 1 || REP_PRO > 1
        {
            const int st_ = ph >= 2 ? (ph - 2) % 10 : -1;
            const int want = ph == 0 ? REP_PRO : (st_ == 4 ? REP_ATT : ((st_ == 0 || st_ == 1 || st_ == 3 || st_ == 5 || st_ == 7 || st_ == 8) ? (((REP_MASK >> st_) & 1) ? REP_GEMM : 1) : 1));
            if (rep_left < 0) rep_left = want - 1;
            if (rep_left > 0) { --rep_left; --ph; __syncthreads(); continue; }
            rep_left = -1;
        }
#endif
        if (ph + 1 < a->ph_hi) {
            if (ph == a->ph_lo) { grid.sync(); bar = xcd_barrier_post(barw, xst); }
            else xcd_barrier(bar);
            for (int e = 0; e < EXTRA_SYNC; ++e) xcd_barrier(bar);
        }
    }
}

#ifndef MK_LAUNCH_PER_PHASE
#define MK_LAUNCH_PER_PHASE 0
#endif
extern "C" void kernel_launch(void* const* d_in, const int* in_sizes, int n_in, void* d_out, int out_size, void* d_ws, size_t ws_size, hipStream_t stream) {
    static int grid = 0;
    if (grid == 0) {
        if (n_in != 20 || out_size != M_LAT * DM || ws_size < WS_END) { fprintf(stderr, "kernel_launch: unexpected shapes (n_in %d out %d ws %zu, need %zu)\n", n_in, out_size, ws_size, (size_t)WS_END); grid = -1; return; }
        int dev = 0, cus = 0, per_cu = 0;
        if (hipGetDevice(&dev) != hipSuccess || hipDeviceGetAttribute(&cus, hipDeviceAttributeMultiprocessorCount, dev) != hipSuccess) { grid = -1; return; }
        if (hipFuncSetAttribute((const void*)mega_fwd, hipFuncAttributeMaxDynamicSharedMemorySize, LDS_BYTES) != hipSuccess) { fprintf(stderr, "kernel_launch: hipFuncSetAttribute failed\n"); grid = -1; return; }
        if (hipOccupancyMaxActiveBlocksPerMultiprocessor(&per_cu, (const void*)mega_fwd, NTHREADS, LDS_BYTES) != hipSuccess || per_cu < 1) { fprintf(stderr, "kernel_launch: occupancy query says %d\n", per_cu); per_cu = 1; }
        (void)hipGetLastError();
        grid = cus;
    }
    if (grid < 0) return;
    Args a{};
    for (int i = 0; i < 20; ++i) a.in[i] = (const float*)d_in[i];
    a.out = (float*)d_out; a.ws = (unsigned char*)d_ws;
    a.lam_init = (float)(0.8 - 0.6 * exp(-0.3 * 2.0));
    constexpr int NPH = 42;
#if MK_LAUNCH_PER_PHASE
    for (int p = 0; p < NPH; ++p) { a.ph_lo = p; a.ph_hi = p + 1; hipLaunchKernelGGL(mega_fwd, dim3(grid), dim3(NTHREADS), LDS_BYTES, stream, a); }
#else
    a.ph_lo = 0; a.ph_hi = NPH;
    void* args[] = {&a};
    hipError_t e = hipLaunchCooperativeKernel((const void*)mega_fwd, dim3(grid), dim3(NTHREADS), args, LDS_BYTES, stream);
    if (e != hipSuccess) fprintf(stderr, "kernel_launch: cooperative launch failed: %s (grid %d)\n", hipGetErrorString(e), grid);
#endif
}
```
